# Optimizing an MI355X kernel written in HIP

```python
import jax, jax.numpy as jnp
from jax import lax
import numpy as np

D_MODEL = 1024
BATCH = 2
SEQ = 8192
DEPTH = 1

CHUNK = 64
D_MIX = D_MODEL
LRU_WIDTH = D_MIX // 2
LRU_HEADS = 8
LRU_HEAD_DIM = LRU_WIDTH // LRU_HEADS
CONV_WIDTH = 4
LRU_C = 8.0
POOL_WIDTH = D_MIX - LRU_WIDTH
POOL_WINDOWS = (2, 4, 8, 16)
POOL_GROUPS = len(POOL_WINDOWS)
POOL_GROUP_DIM = POOL_WIDTH // POOL_GROUPS
D_IN = 2 * LRU_WIDTH + POOL_WIDTH
D_FF = ((8 * D_MODEL // 3 + 255) // 256) * 256
EPS = 1e-6

kernel_name = "hybrid_rglru_multiscale_pool_swiglu"


def rmsnorm(x, g):
    xf = x.astype(jnp.float32)
    return xf * lax.rsqrt(jnp.mean(xf * xf, axis=-1, keepdims=True) + EPS) * g.astype(jnp.float32)


def causal_depthwise_conv(x, w, b):
    S = x.shape[1]
    xp = jnp.pad(x, ((0, 0), (CONV_WIDTH - 1, 0), (0, 0)))
    out = b
    for k in range(CONV_WIDTH):
        out = out + xp[:, k:k + S, :] * w[k]
    return out


def rg_lru(x, wa, ba, wx, bx, lam):
    B, S, _ = x.shape
    xh = x.reshape(B, S, LRU_HEADS, LRU_HEAD_DIM)
    r = jax.nn.sigmoid(jnp.einsum('bshi,hij->bshj', xh, wa).reshape(B, S, LRU_WIDTH) + ba)
    i = jax.nn.sigmoid(jnp.einsum('bshi,hij->bshj', xh, wx).reshape(B, S, LRU_WIDTH) + bx)
    log_a = -LRU_C * r * jax.nn.softplus(-lam)
    a = jnp.exp(log_a)
    mult = jnp.sqrt(jnp.maximum(-jnp.expm1(2.0 * log_a), 1e-12))
    b = mult * (i * x)

    def combine(left, right):
        a1, b1 = left
        a2, b2 = right
        return a1 * a2, a2 * b1 + b2

    _, h = lax.associative_scan(combine, (a, b), axis=1)
    return h


def trailing_mean(x, w):
    S = x.shape[1]
    cs = jnp.cumsum(jnp.pad(x, ((0, 0), (w, 0), (0, 0))), axis=1)
    window_sum = cs[:, w:, :] - cs[:, :S, :]
    count = jnp.minimum(jnp.arange(1, S + 1), w).astype(jnp.float32)[None, :, None]
    return window_sum / count


def pool_mixer(u, pool_w, pool_b, pool_scale):
    B, S, _ = u.shape
    ug = u.reshape(B, S, POOL_GROUPS, POOL_GROUP_DIM)
    pooled = jnp.stack(
        [trailing_mean(ug[:, :, g, :], w) - ug[:, :, g, :] for g, w in enumerate(POOL_WINDOWS)],
        axis=2)
    y = jnp.einsum('bsgc,gcd->bsgd', pooled, pool_w).reshape(B, S, POOL_WIDTH) + pool_b
    return y * pool_scale


def setup_inputs(seed: int = 0) -> dict:
    key = jax.random.key(seed)
    ks = jax.random.split(key, 24)
    f32 = jnp.float32
    nrm = lambda k, shape, fan_in: jax.random.normal(k, shape, f32) * (fan_in ** -0.5)
    gain = lambda k, shape: 1.0 + 0.02 * jax.random.normal(k, shape, f32)
    small = lambda k, shape: 0.01 * jax.random.normal(k, shape, f32)
    u = jax.random.uniform(ks[8], (DEPTH, LRU_WIDTH), f32, minval=0.9, maxval=0.999)
    a0 = u ** (1.0 / LRU_C)
    lam = jnp.log(a0) - jnp.log1p(-a0)
    return {
        "x": jax.random.normal(ks[0], (BATCH, SEQ, D_MODEL), f32),
        "norm_mix_g": gain(ks[1], (DEPTH, D_MODEL)),
        "w_in": nrm(ks[2], (DEPTH, D_MODEL, D_IN), D_MODEL),
        "conv_w": nrm(ks[3], (DEPTH, CONV_WIDTH, LRU_WIDTH), CONV_WIDTH),
        "conv_b": small(ks[4], (DEPTH, LRU_WIDTH)),
        "gate_a_w": nrm(ks[5], (DEPTH, LRU_HEADS, LRU_HEAD_DIM, LRU_HEAD_DIM), LRU_HEAD_DIM),
        "gate_a_b": small(ks[6], (DEPTH, LRU_WIDTH)),
        "gate_x_w": nrm(ks[7], (DEPTH, LRU_HEADS, LRU_HEAD_DIM, LRU_HEAD_DIM), LRU_HEAD_DIM),
        "gate_x_b": small(ks[9], (DEPTH, LRU_WIDTH)),
        "lru_lambda": lam,
        "pool_w": nrm(ks[10], (DEPTH, POOL_GROUPS, POOL_GROUP_DIM, POOL_GROUP_DIM), POOL_GROUP_DIM),
        "pool_b": small(ks[11], (DEPTH, POOL_WIDTH)),
        "pool_scale": gain(ks[12], (DEPTH, POOL_WIDTH)),
        "norm_lru_g": gain(ks[13], (DEPTH, LRU_WIDTH)),
        "norm_pool_g": gain(ks[14], (DEPTH, POOL_WIDTH)),
        "w_out": nrm(ks[15], (DEPTH, D_MIX, D_MODEL), D_MIX),
        "norm_ffn_g": gain(ks[16], (DEPTH, D_MODEL)),
        "ffn_w1": nrm(ks[17], (DEPTH, D_MODEL, D_FF), D_MODEL),
        "ffn_w3": nrm(ks[18], (DEPTH, D_MODEL, D_FF), D_MODEL),
        "ffn_w2": nrm(ks[19], (DEPTH, D_FF, D_MODEL), D_FF),
        "final_norm_g": gain(ks[20], (D_MODEL,)),
    }


def reference(x, norm_mix_g, w_in, conv_w, conv_b, gate_a_w, gate_a_b, gate_x_w, gate_x_b,
              lru_lambda, pool_w, pool_b, pool_scale, norm_lru_g, norm_pool_g, w_out,
              norm_ffn_g, ffn_w1, ffn_w3, ffn_w2, final_norm_g):
    out_dtype = x.dtype
    h_res = x.astype(jnp.float32)
    for l in range(DEPTH):
        h = rmsnorm(h_res, norm_mix_g[l])
        u = h @ w_in[l].astype(jnp.float32)
        u_lru = u[..., :LRU_WIDTH]
        u_gate = u[..., LRU_WIDTH:2 * LRU_WIDTH]
        u_pool = u[..., 2 * LRU_WIDTH:]
        xc = causal_depthwise_conv(u_lru, conv_w[l], conv_b[l])
        y_lru = rg_lru(xc, gate_a_w[l], gate_a_b[l], gate_x_w[l], gate_x_b[l], lru_lambda[l])
        y_lru = y_lru * jax.nn.gelu(u_gate, approximate=True)
        y_pool = pool_mixer(u_pool, pool_w[l], pool_b[l], pool_scale[l])
        y = jnp.concatenate([rmsnorm(y_lru, norm_lru_g[l]), rmsnorm(y_pool, norm_pool_g[l])], axis=-1)
        h_res = h_res + y @ w_out[l].astype(jnp.float32)
        h = rmsnorm(h_res, norm_ffn_g[l])
        ff = jax.nn.silu(h @ ffn_w1[l].astype(jnp.float32)) * (h @ ffn_w3[l].astype(jnp.float32))
        h_res = h_res + ff @ ffn_w2[l].astype(jnp.float32)
    return rmsnorm(h_res, final_norm_g).astype(out_dtype)
```

```cpp
#include <hip/hip_runtime.h>
#include <hip/hip_cooperative_groups.h>
#include <cstdio>
#include <cstdint>
namespace cg = cooperative_groups;
namespace pg8 {
#define PG8_LAS __attribute__((address_space(3)))
typedef unsigned short bf16_t;
typedef short bf16x8 __attribute__((ext_vector_type(8)));
typedef float f32x4 __attribute__((ext_vector_type(4)));
typedef unsigned u32x4 __attribute__((ext_vector_type(4)));
constexpr int BM = 256, BK = 64, HALF = 128, HTB = HALF * BK * 2  , STAGE_BYTES = 8 * HTB, NXCD = 8, WGM = 8;

__host__ __device__ __forceinline__ int lds_byte(int r, int c) { const int st = (r >> 4) * 2 + (c >> 5), rr = r & 15, cc = c & 31, ob = rr * 64 + cc * 2; return st * 1024 + (ob ^ (((ob >> 9) & 1) << 5)); }
__host__ __device__ __forceinline__ void stage_rc(int b, int& R, int& C) { const int st = b / 1024, sb = b % 1024, swz = sb ^ (((sb >> 9) & 1) << 5); R = (st >> 1) * 16 + swz / 64; C = (st & 1) * 32 + (swz % 64) / 2; }
__host__ __device__ __forceinline__ int perm32(int rho) { const int n = rho >> 4, i = rho & 15; return 8 * (i >> 2) + 4 * n + (i & 3); }

struct Unit { int pm, pn, half; };
struct Gemm { const bf16_t* A; const bf16_t* Bt; int M, N, K, btiled; };

struct StaticOrder {
    int nM, nN, nwg, G, c;
    __host__ __device__ void init(int M, int N, int G_, int c_) { nM = M / BM; nN = N / BM; nwg = nM * nN; G = G_; c = c_; }
    __host__ __device__ bool next(int i, Unit& u) const {
        const long L = (long)i * G + c; if (L >= nwg) return false;
        int wgid = (int)L; { const int q = nwg / NXCD, r = nwg % NXCD, xcd = wgid % NXCD, off = wgid / NXCD; wgid = (xcd < r ? xcd * (q + 1) : r * (q + 1) + (xcd - r) * q) + off; }
        const int nig = WGM * nN, gid = wgid / nig, fm = gid * WGM, gsz = (nM - fm) < WGM ? (nM - fm) : WGM;
        u.pm = fm + ((wgid % nig) % gsz); u.pn = (wgid % nig) / gsz; u.half = 0; return true;
    }
    __device__ __forceinline__ void a_ready(const Unit&) const {}
    __device__ __forceinline__ void done(const Unit&) const {}
};

struct TailSplitOrder : StaticOrder {
    __host__ __device__ bool next(int i, Unit& u) const {
        const int R = nwg / G;
        if (i < R) return StaticOrder::next(i, u);
        if (i > R || (nwg - R * G) * 2 != G) return (i == R) ? StaticOrder::next(i, u) : false;
        StaticOrder t = *this; t.c = 0; t.G = 1;
        if (!t.next(R * G + (c >> 1), u)) return false;
        u.half = 1 + (c & 1); return true;
    }
};
template <int ROT> struct RotOrder : StaticOrder {
    __host__ __device__ bool next(int i, Unit& u) const { if (!StaticOrder::next(i, u)) return false; u.pn = (u.pn + ROT) % nN; return true; }
};

__device__ __forceinline__ unsigned cvt_pk_bf16(float lo, float hi) { unsigned r; asm volatile("v_cvt_pk_bf16_f32 %0, %1, %2" : "=v"(r) : "v"(lo), "v"(hi)); return r; }
typedef float f32x2 __attribute__((ext_vector_type(2)));
#ifndef WT_STORES
#define WT_STORES 0
#endif
__device__ __forceinline__ void st16(void* p, u32x4 v) {
#if WT_STORES
    asm volatile("global_store_dwordx4 %0, %1, off sc1\n\ts_nop 1" :: "v"(p), "v"(v) : "memory");
#else
    *(u32x4*)p = v;
#endif
}
struct EpiU {
    static constexpr bool PERM = true, AFTER_DRAIN = false, HAS_PRE = false;
    bf16_t* O; int ldc;
    static __device__ __forceinline__ f32x2 gelu2(f32x2 v) {
        const f32x2 c0 = (f32x2){-2.302208198f, -2.302208198f}, c1 = (f32x2){0.044715f * -2.302208198f, 0.044715f * -2.302208198f}, one = (f32x2){1.0f, 1.0f};
        const f32x2 z = v * ((v * v) * c1 + c0); f32x2 e; e.x = __builtin_amdgcn_exp2f(z.x); e.y = __builtin_amdgcn_exp2f(z.y);
        const f32x2 d = e + one; f32x2 r; r.x = __builtin_amdgcn_rcpf(d.x); r.y = __builtin_amdgcn_rcpf(d.y); return v * r;
    }
    __device__ __forceinline__ void operator()(const f32x4 (&acc)[2][2][4][2], const Unit& u, int wr, int wc, int fr, int fq) const {
        const int row0 = u.pm * BM + wr * 64 + fr, col0 = u.pn * BM + wc * 32 + 8 * fq;
        const bool gate = (u.pn == 2) || (u.pn == 3);
#pragma unroll
        for (int ai = 0; ai < 2; ++ai)
#pragma unroll
            for (int m = 0; m < 4; ++m) { bf16_t* rowp = O + (size_t)(row0 + ai * HALF + m * 16) * ldc + col0;
#pragma unroll
                for (int bj = 0; bj < 2; ++bj) { f32x4 v0 = acc[ai][bj][m][0], v1 = acc[ai][bj][m][1];
                    if (gate) { const f32x2 a = gelu2((f32x2){v0[0], v0[1]}), b = gelu2((f32x2){v0[2], v0[3]}), c = gelu2((f32x2){v1[0], v1[1]}), d = gelu2((f32x2){v1[2], v1[3]});
                        v0 = (f32x4){a.x, a.y, b.x, b.y}; v1 = (f32x4){c.x, c.y, d.x, d.y}; }
                    u32x4 w; w.x = cvt_pk_bf16(v0[0], v0[1]); w.y = cvt_pk_bf16(v0[2], v0[3]); w.z = cvt_pk_bf16(v1[0], v1[1]); w.w = cvt_pk_bf16(v1[2], v1[3]);
                    st16(rowp + bj * HALF, w); } }
    }
};
template <bool WB> struct EpiRes {
    static constexpr bool PERM = true, AFTER_DRAIN = false, HAS_PRE = false;
    const float* base; float* out; bf16_t* ob; float* rowss;
    __device__ __forceinline__ void operator()(const f32x4 (&acc)[2][2][4][2], const Unit& u, int wr, int wc, int fr, int fq) const {
        const int row0 = u.pm * BM + wr * 64 + fr, col0 = u.pn * BM + wc * 32 + 8 * fq;
#pragma unroll
        for (int ai = 0; ai < 2; ++ai) {
            f32x4 bv[4][2][2];
#pragma unroll
            for (int m = 0; m < 4; ++m)
#pragma unroll
                for (int bj = 0; bj < 2; ++bj) { const float* p = base + (size_t)(row0 + ai * HALF + m * 16) * 1024 + col0 + bj * HALF; bv[m][bj][0] = *(const f32x4*)p; bv[m][bj][1] = *(const f32x4*)(p + 4); }
#pragma unroll
            for (int m = 0; m < 4; ++m) { const int row = row0 + ai * HALF + m * 16; const size_t off = (size_t)row * 1024 + col0; float ss = 0.f;
#pragma unroll
                for (int bj = 0; bj < 2; ++bj) { const size_t p = off + bj * HALF;
                    const f32x4 v0 = acc[ai][bj][m][0] + bv[m][bj][0], v1 = acc[ai][bj][m][1] + bv[m][bj][1];
                    *(f32x4*)(out + p) = v0; *(f32x4*)(out + p + 4) = v1;
                    { const f32x4 sq4 = v0 * v0 + v1 * v1; ss += (sq4[0] + sq4[1]) + (sq4[2] + sq4[3]); }
                    if (WB) { u32x4 w; w.x = cvt_pk_bf16(v0[0], v0[1]); w.y = cvt_pk_bf16(v0[2], v0[3]); w.z = cvt_pk_bf16(v1[0], v1[1]); w.w = cvt_pk_bf16(v1[2], v1[3]); *(u32x4*)(ob + p) = w; } }
                ss += __shfl_xor(ss, 16); ss += __shfl_xor(ss, 32);
                if (fq == 0) unsafeAtomicAdd(rowss + row, ss); }
            asm volatile("" ::: "memory"); }
    }
};
struct EpiRes3 {
    static constexpr bool PERM = true, AFTER_DRAIN = false, HAS_PRE = false;
    const float* base; bf16_t* ob; float* rowss;
    __device__ __forceinline__ void operator()(const f32x4 (&acc)[2][2][4][2], const Unit& u, int wr, int wc, int fr, int fq) const {
        const int row0 = u.pm * BM + wr * 64 + fr, col0 = u.pn * BM + wc * 32 + 8 * fq;
#pragma unroll
        for (int ai = 0; ai < 2; ++ai) {
            f32x4 bv[4][2][2];
#pragma unroll
            for (int m = 0; m < 4; ++m)
#pragma unroll
                for (int bj = 0; bj < 2; ++bj) { const float* p = base + (size_t)(row0 + ai * HALF + m * 16) * 1024 + col0 + bj * HALF; bv[m][bj][0] = *(const f32x4*)p; bv[m][bj][1] = *(const f32x4*)(p + 4); }
#pragma unroll
            for (int m = 0; m < 4; ++m) { const int row = row0 + ai * HALF + m * 16; const size_t off = (size_t)row * 1024 + col0; float ss = 0.f;
#pragma unroll
                for (int bj = 0; bj < 2; ++bj) { const size_t p = off + bj * HALF;
                    const f32x4 v0 = acc[ai][bj][m][0] + bv[m][bj][0], v1 = acc[ai][bj][m][1] + bv[m][bj][1];
                    { const f32x4 sq4 = v0 * v0 + v1 * v1; ss += (sq4[0] + sq4[1]) + (sq4[2] + sq4[3]); }
                    u32x4 w; w.x = cvt_pk_bf16(v0[0], v0[1]); w.y = cvt_pk_bf16(v0[2], v0[3]); w.z = cvt_pk_bf16(v1[0], v1[1]); w.w = cvt_pk_bf16(v1[2], v1[3]); st16(ob + p, w); }
                ss += __shfl_xor(ss, 16); ss += __shfl_xor(ss, 32);
                if (fq == 0) unsafeAtomicAdd(rowss + row, ss); }
            asm volatile("" ::: "memory"); }
    }
};
struct EpiRes5 {
    static constexpr bool PERM = true, AFTER_DRAIN = false, HAS_PRE = false;
    const bf16_t* hb; float* out; float* rowss;
    __device__ __forceinline__ void operator()(const f32x4 (&acc)[2][2][4][2], const Unit& u, int wr, int wc, int fr, int fq) const {
        const int row0 = u.pm * BM + wr * 64 + fr, col0 = u.pn * BM + wc * 32 + 8 * fq;
#pragma unroll
        for (int ai = 0; ai < 2; ++ai) {
            u32x4 bv[4][2];
#pragma unroll
            for (int m = 0; m < 4; ++m)
#pragma unroll
                for (int bj = 0; bj < 2; ++bj) bv[m][bj] = *(const u32x4*)(hb + (size_t)(row0 + ai * HALF + m * 16) * 1024 + col0 + bj * HALF);
#pragma unroll
            for (int m = 0; m < 4; ++m) { const int row = row0 + ai * HALF + m * 16; const size_t off = (size_t)row * 1024 + col0; float ss = 0.f;
#pragma unroll
                for (int bj = 0; bj < 2; ++bj) { const size_t p = off + bj * HALF; const u32x4 h = bv[m][bj];
                    const f32x4 r0 = (f32x4){__uint_as_float(h.x << 16), __uint_as_float(h.x & 0xffff0000u), __uint_as_float(h.y << 16), __uint_as_float(h.y & 0xffff0000u)};
                    const f32x4 r1 = (f32x4){__uint_as_float(h.z << 16), __uint_as_float(h.z & 0xffff0000u), __uint_as_float(h.w << 16), __uint_as_float(h.w & 0xffff0000u)};
                    const f32x4 v0 = acc[ai][bj][m][0] + r0, v1 = acc[ai][bj][m][1] + r1;
                    *(f32x4*)(out + p) = v0; *(f32x4*)(out + p + 4) = v1;
                    { const f32x4 sq4 = v0 * v0 + v1 * v1; ss += (sq4[0] + sq4[1]) + (sq4[2] + sq4[3]); } }
                ss += __shfl_xor(ss, 16); ss += __shfl_xor(ss, 32);
                if (fq == 0) unsafeAtomicAdd(rowss + row, ss); }
            asm volatile("" ::: "memory"); }
    }
};
struct EpiFinal {
    static constexpr bool PERM = true, AFTER_DRAIN = true, HAS_PRE = false;
    const bf16_t* hb; float* out; const float* gfin; float* xbuf; unsigned* cnt;
    __device__ __forceinline__ void preload(const Unit& u, int wr, int wc, int fr, int fq, u32x4 (&pbv)[2][4][2]) const {
        const int row0 = u.pm * BM + wr * 64 + fr, col0 = u.pn * BM + wc * 32 + 8 * fq;
#pragma unroll
        for (int ai = 0; ai < 2; ++ai)
#pragma unroll
            for (int m = 0; m < 4; ++m)
#pragma unroll
                for (int bj = 0; bj < 2; ++bj) pbv[ai][m][bj] = *(const u32x4*)(hb + (size_t)(row0 + ai * HALF + m * 16) * 1024 + col0 + bj * HALF);
    }
    __device__ __forceinline__ void fused(f32x4 (&acc)[2][2][4][2], const Unit& u, int wr, int wc, int fr, int fq, PG8_LAS unsigned char* lds, int wid, int lane, const u32x4 (&pbv)[2][4][2]) const {
        PG8_LAS float* P = (PG8_LAS float*)lds;
        PG8_LAS float* S = (PG8_LAS float*)(lds + 4096);
        const int row0 = u.pm * BM + wr * 64 + fr, col0 = u.pn * BM + wc * 32 + 8 * fq;
#pragma unroll
        for (int ai = 0; ai < 2; ++ai) {
#pragma unroll
            for (int m = 0; m < 4; ++m) { float ss = 0.f;
#pragma unroll
                for (int bj = 0; bj < 2; ++bj) { const u32x4 h = pbv[ai][m][bj];
                    const f32x4 r0 = (f32x4){__uint_as_float(h.x << 16), __uint_as_float(h.x & 0xffff0000u), __uint_as_float(h.y << 16), __uint_as_float(h.y & 0xffff0000u)};
                    const f32x4 r1 = (f32x4){__uint_as_float(h.z << 16), __uint_as_float(h.z & 0xffff0000u), __uint_as_float(h.w << 16), __uint_as_float(h.w & 0xffff0000u)};
                    const f32x4 v0 = acc[ai][bj][m][0] + r0, v1 = acc[ai][bj][m][1] + r1; acc[ai][bj][m][0] = v0; acc[ai][bj][m][1] = v1;
                    { const f32x4 sq4 = v0 * v0 + v1 * v1; ss += (sq4[0] + sq4[1]) + (sq4[2] + sq4[3]); } }
                ss += __shfl_xor(ss, 16); ss += __shfl_xor(ss, 32);
                if (fq == 0) P[(ai * HALF + wr * 64 + m * 16 + fr) * 4 + wc] = ss; }
            asm volatile("" ::: "memory"); }
        asm volatile("s_waitcnt lgkmcnt(0)" ::: "memory"); __builtin_amdgcn_s_barrier(); asm volatile("" ::: "memory");
        const int row = wid * 32 + (lane & 31);
        if (lane < 32) { const f32x4 p = *(const PG8_LAS f32x4*)(P + row * 4);
            __hip_atomic_store(xbuf + ((size_t)(u.pm * BM + row) * 4 + u.pn), (p[0] + p[1]) + (p[2] + p[3]), __ATOMIC_RELAXED, __HIP_MEMORY_SCOPE_AGENT); }
        asm volatile("s_waitcnt vmcnt(0)" ::: "memory");
        if (lane == 0) __hip_atomic_fetch_add(cnt + 64 * u.pm, 1u, __ATOMIC_RELAXED, __HIP_MEMORY_SCOPE_AGENT);
        if (wid == 0) { unsigned sp = 0;
            while ((unsigned)__builtin_amdgcn_readfirstlane(__hip_atomic_load(cnt + 64 * u.pm, __ATOMIC_RELAXED, __HIP_MEMORY_SCOPE_AGENT)) < 32u) { __builtin_amdgcn_s_sleep(2); if (++sp > (1u << 20)) break; }
            __builtin_amdgcn_fence(__ATOMIC_ACQUIRE, "agent"); }
        asm volatile("s_waitcnt vmcnt(0) lgkmcnt(0)" ::: "memory"); __builtin_amdgcn_s_barrier(); asm volatile("" ::: "memory");
        if (lane < 32) { const float* slot = xbuf + (size_t)(u.pm * BM + row) * 4; float t = 0.f;
#pragma unroll
            for (int k = 0; k < 4; ++k) t += __hip_atomic_load(slot + k, __ATOMIC_RELAXED, __HIP_MEMORY_SCOPE_AGENT);
            S[row] = __builtin_amdgcn_rsqf(t * (1.0f / 1024.0f) + 1e-6f); }
        asm volatile("s_waitcnt vmcnt(0) lgkmcnt(0)" ::: "memory"); __builtin_amdgcn_s_barrier(); asm volatile("" ::: "memory");
        f32x4 gv[2][2];
#pragma unroll
        for (int bj = 0; bj < 2; ++bj) { gv[bj][0] = *(const f32x4*)(gfin + col0 + bj * HALF); gv[bj][1] = *(const f32x4*)(gfin + col0 + bj * HALF + 4); }
#pragma unroll
        for (int ai = 0; ai < 2; ++ai)
#pragma unroll
            for (int m = 0; m < 4; ++m) { const int r = ai * HALF + wr * 64 + m * 16 + fr; const float rs = S[r]; float* op = out + (size_t)(u.pm * BM + r) * 1024 + col0;
#pragma unroll
                for (int bj = 0; bj < 2; ++bj) { *(f32x4*)(op + bj * HALF) = acc[ai][bj][m][0] * rs * gv[bj][0]; *(f32x4*)(op + bj * HALF + 4) = acc[ai][bj][m][1] * rs * gv[bj][1]; } }
    }
};
struct EpiFfn {
    static constexpr bool PERM = true, AFTER_DRAIN = false, HAS_PRE = true;
    bf16_t* O; const float* rowss;
    __device__ __forceinline__ void prefetch(const Unit& u, int wr, int wc, int fr, int fq, float (&pre)[8]) const {
        const int row0 = u.pm * BM + (u.half == 2 ? HALF : 0) + wr * 64 + fr;
#pragma unroll
        for (int ai = 0; ai < 2; ++ai)
#pragma unroll
            for (int m = 0; m < 4; ++m) pre[ai * 4 + m] = rowss[row0 + ai * HALF + m * 16];
    }
    __device__ __forceinline__ void operator()(const f32x4 (&acc)[2][2][4][2], const Unit& u, int wr, int wc, int fr, int fq, const float (&pre)[8]) const {
        const int row0 = u.pm * BM + (u.half == 2 ? HALF : 0) + wr * 64 + fr, col0 = u.pn * HALF + wc * 32 + 8 * fq;
#pragma unroll
        for (int ai = 0; ai < 2; ++ai) { if (ai == 1 && u.half != 0) break;
#pragma unroll
            for (int m = 0; m < 4; ++m) { const int row = row0 + ai * HALF + m * 16; const float rstd = __builtin_amdgcn_rsqf(pre[ai * 4 + m] * (1.0f / 1024.0f) + 1e-6f);
                const float r2 = rstd * rstd, nrl = rstd * -1.44269504f;
                const f32x2 r2v = (f32x2){r2, r2}, nrlv = (f32x2){nrl, nrl}, onev = (f32x2){1.0f, 1.0f};
                f32x2 fp[4];
#pragma unroll
                for (int n = 0; n < 2; ++n)
#pragma unroll
                    for (int hh = 0; hh < 2; ++hh) { const f32x4 a4 = acc[ai][0][m][n], b4 = acc[ai][1][m][n];
                        const f32x2 a = hh ? (f32x2){a4[2], a4[3]} : (f32x2){a4[0], a4[1]}, b = hh ? (f32x2){b4[2], b4[3]} : (f32x2){b4[0], b4[1]};
                        const f32x2 t = a * nrlv; f32x2 e; e.x = __builtin_amdgcn_exp2f(t.x); e.y = __builtin_amdgcn_exp2f(t.y);
                        const f32x2 d = e + onev; f32x2 sg; sg.x = __builtin_amdgcn_rcpf(d.x); sg.y = __builtin_amdgcn_rcpf(d.y);
                        fp[n * 2 + hh] = ((a * b) * r2v) * sg; }
                u32x4 w; w.x = cvt_pk_bf16(fp[0].x, fp[0].y); w.y = cvt_pk_bf16(fp[1].x, fp[1].y); w.z = cvt_pk_bf16(fp[2].x, fp[2].y); w.w = cvt_pk_bf16(fp[3].x, fp[3].y);
                st16(O + (size_t)row * 2816 + col0, w); } }
    }
};

template <class Epi, class Sched, bool ALIGN_EPI = false, bool SP2 = false>
__device__ __forceinline__ void gemm_phase(PG8_LAS unsigned char* lds, const Gemm g, const Sched& S, const Epi& E) {
    int tid_l; asm volatile("v_mov_b32 %0, %1" : "=v"(tid_l) : "v"(threadIdx.x));
    const int tid = tid_l, wid = __builtin_amdgcn_readfirstlane(tid >> 6), lane = tid & 63, wr = wid >> 2, wc = wid & 3, fr = lane & 15, fq = lane >> 4;
    const int K = g.K, nt = K / BK;
    unsigned voffA[2], voffB[2];
#pragma unroll
    for (int i = 0; i < 2; ++i) { int R, C; stage_rc(tid * 16 + i * 8192, R, C); const int Rb = Epi::PERM ? ((R & ~31) + perm32(R & 31)) : R;
        voffA[i] = (unsigned)(R * K + C) * 2u; voffB[i] = (unsigned)(Rb * (g.btiled ? BK : K) + C) * 2u; }
    const size_t kstep = (size_t)(BK * 2);
    const size_t hstep = (size_t)HALF * K * 2;
    const size_t tstep = 2 * hstep; const size_t kstepB = g.btiled ? (size_t)(BM * BK * 2) : kstep, hstepB = g.btiled ? (size_t)(HALF * BK * 2) : hstep;
    const unsigned ldsw = (unsigned)wid * 1024u;
    const int aoff = lds_byte(wr * 64 + fr, fq * 8), boff = lds_byte(wc * 32 + fr, fq * 8);
#define PG8_SA(b, h) (((b) * 2 + (h)) * HTB)
#define PG8_SB(b, h) ((4 + (b) * 2 + (h)) * HTB)
#define PG8_STAGE(bufoff, gbase, voff) do { _Pragma("unroll") for (int _i = 0; _i < 2; ++_i) \
        __builtin_amdgcn_global_load_lds((const unsigned*)((const char*)(gbase) + (voff)[_i]), (PG8_LAS unsigned*)(lds + (bufoff) + ldsw + _i * 8192), 16, 0, 0); } while (0)
#define PG8_LDA(dst, b, h) do { _Pragma("unroll") for (int m = 0; m < 4; ++m) _Pragma("unroll") for (int k = 0; k < 2; ++k) dst[m][k] = *(const PG8_LAS bf16x8*)(lds + PG8_SA(b, h) + aoff + m * 2048 + k * 1024); } while (0)
#define PG8_LDB(dst, b, h) do { _Pragma("unroll") for (int n = 0; n < 2; ++n) _Pragma("unroll") for (int k = 0; k < 2; ++k) dst[n][k] = *(const PG8_LAS bf16x8*)(lds + PG8_SB(b, h) + boff + n * 2048 + k * 1024); } while (0)
#define PG8_MMA(ai, bj, At, Bt) do { __builtin_amdgcn_s_setprio(1); _Pragma("unroll") for (int m = 0; m < 4; ++m) _Pragma("unroll") for (int n = 0; n < 2; ++n) _Pragma("unroll") for (int k = 0; k < 2; ++k) \
        acc[ai][bj][m][n] = __builtin_amdgcn_mfma_f32_16x16x32_bf16(Bt[n][k], At[m][k], acc[ai][bj][m][n], 0, 0, 0); __builtin_amdgcn_s_setprio(0); } while (0)
#define PG8_WAIT_V(n) asm volatile("s_waitcnt vmcnt(" #n ")" ::: "memory")
#define PG8_WAIT_L(n) asm volatile("s_waitcnt lgkmcnt(" #n ")" ::: "memory")
#define PG8_BAR __builtin_amdgcn_s_barrier()
#define PG8_SCHED __builtin_amdgcn_sched_barrier(0)
    Unit cur, nxt; int ui = 0;
    if (!S.next(0, cur)) return;
    f32x4 acc[2][2][4][2];
#pragma unroll
    for (int a = 0; a < 2; ++a)
#pragma unroll
        for (int b = 0; b < 2; ++b)
#pragma unroll
            for (int m = 0; m < 4; ++m)
#pragma unroll
                for (int n = 0; n < 2; ++n) acc[a][b][m][n] = (f32x4){0.f, 0.f, 0.f, 0.f};
    bf16x8 At[4][2], B0[2][2], B1[2][2];
    const char* cA = (const char*)g.A + (size_t)cur.pm * tstep + (cur.half == 2 ? hstep : (size_t)0); const char* cB = (const char*)g.Bt + (size_t)cur.pn * tstep;
    float pre[8];
    if constexpr (Epi::HAS_PRE) E.prefetch(cur, wr, wc, fr, fq, pre);
    S.a_ready(cur);
    if constexpr (SP2) {
        PG8_STAGE(PG8_SB(0, 0), cB, voffB); PG8_STAGE(PG8_SB(0, 1), cB + hstepB, voffB); PG8_STAGE(PG8_SA(0, 0), cA, voffA); PG8_STAGE(PG8_SA(0, 1), cA + hstep, voffA);
        if (wr == 1) PG8_BAR;
        PG8_WAIT_V(2); PG8_BAR;
        PG8_STAGE(PG8_SB(1, 0), cB + kstepB, voffB); PG8_STAGE(PG8_SA(1, 0), cA + kstep, voffA); PG8_STAGE(PG8_SB(1, 1), cB + hstepB + kstepB, voffB);
        PG8_WAIT_V(6); PG8_BAR;
    } else {
        PG8_STAGE(PG8_SB(0, 0), cB, voffB); PG8_STAGE(PG8_SA(0, 0), cA, voffA); PG8_STAGE(PG8_SB(0, 1), cB + hstepB, voffB); PG8_STAGE(PG8_SA(0, 1), cA + hstep, voffA);
        if (wr == 1) PG8_BAR;
        PG8_WAIT_V(4); PG8_BAR;
        PG8_STAGE(PG8_SB(1, 0), cB + kstepB, voffB); PG8_STAGE(PG8_SA(1, 0), cA + kstep, voffA); PG8_STAGE(PG8_SB(1, 1), cB + hstepB + kstepB, voffB);
        PG8_WAIT_V(6); PG8_BAR;
    }
    for (;;) {
        const bool has_next = S.next(ui + 1, nxt);
        const char* nA = has_next ? (const char*)g.A + (size_t)nxt.pm * tstep + (nxt.half == 2 ? hstep : (size_t)0) : cA; const char* nB = has_next ? (const char*)g.Bt + (size_t)nxt.pn * tstep : cB;
        const bool fullu = (cur.half == 0);
        for (int t = 0; t < nt; t += 2) {
            const bool last = (t == nt - 2);
            const char* a1 = cA + (size_t)(t + 1) * kstep;
            const char* a2 = last ? nA : cA + (size_t)(t + 2) * kstep; const char* b2 = last ? nB : cB + (size_t)(t + 2) * kstepB;
            const char* a3 = a2 + kstep; const char* b3 = b2 + kstepB;
            if (last && has_next) S.a_ready(nxt);
            if constexpr (SP2) {
            PG8_LDB(B0, 0, 0); PG8_LDB(B1, 0, 1); PG8_SCHED; PG8_LDA(At, 0, 0); PG8_STAGE(PG8_SA(1, 1), a1 + hstep, voffA);
            PG8_WAIT_V(8); PG8_WAIT_L(0); PG8_BAR; PG8_MMA(0, 0, At, B0); PG8_MMA(0, 1, At, B1); PG8_BAR; PG8_SCHED;
            PG8_LDA(At, 0, 1); PG8_STAGE(PG8_SB(0, 0), b2, voffB); PG8_STAGE(PG8_SB(0, 1), b2 + hstepB, voffB); PG8_STAGE(PG8_SA(0, 0), a2, voffA);
            PG8_WAIT_V(8); PG8_WAIT_L(0); PG8_BAR; if (fullu) { PG8_MMA(1, 0, At, B0); PG8_MMA(1, 1, At, B1); } PG8_BAR; PG8_SCHED;
            PG8_LDB(B0, 1, 0); PG8_LDB(B1, 1, 1); PG8_SCHED; PG8_LDA(At, 1, 0); PG8_STAGE(PG8_SA(0, 1), a2 + hstep, voffA);
            PG8_WAIT_V(8); PG8_WAIT_L(0); PG8_BAR; PG8_MMA(0, 0, At, B0); PG8_MMA(0, 1, At, B1); PG8_BAR; PG8_SCHED;
            PG8_LDA(At, 1, 1); PG8_STAGE(PG8_SB(1, 0), b3, voffB); PG8_STAGE(PG8_SB(1, 1), b3 + hstepB, voffB); PG8_STAGE(PG8_SA(1, 0), a3, voffA);
            PG8_WAIT_V(8); PG8_WAIT_L(0); PG8_BAR; if (fullu) { PG8_MMA(1, 0, At, B0); PG8_MMA(1, 1, At, B1); } PG8_BAR; PG8_SCHED;
            } else {
            PG8_LDB(B0, 0, 0); PG8_SCHED; PG8_LDA(At, 0, 0); PG8_STAGE(PG8_SA(1, 1), a1 + hstep, voffA);
            PG8_WAIT_L(8); PG8_BAR; PG8_WAIT_L(0); PG8_MMA(0, 0, At, B0); PG8_BAR; PG8_SCHED;
            PG8_LDB(B1, 0, 1); PG8_STAGE(PG8_SB(0, 0), b2, voffB);
            PG8_BAR; PG8_WAIT_L(0); PG8_MMA(0, 1, At, B1); PG8_BAR;
            PG8_LDA(At, 0, 1); PG8_STAGE(PG8_SA(0, 0), a2, voffA);
            PG8_BAR; PG8_WAIT_L(0); PG8_MMA(1, 0, At, B0); PG8_BAR; PG8_SCHED;
            PG8_STAGE(PG8_SB(0, 1), b2 + hstepB, voffB);
            PG8_WAIT_V(6); PG8_BAR; PG8_MMA(1, 1, At, B1); PG8_BAR;
            PG8_LDB(B0, 1, 0); PG8_SCHED; PG8_LDA(At, 1, 0); PG8_STAGE(PG8_SA(0, 1), a2 + hstep, voffA);
            PG8_WAIT_L(8); PG8_BAR; PG8_WAIT_L(0); PG8_MMA(0, 0, At, B0); PG8_BAR; PG8_SCHED;
            PG8_LDB(B1, 1, 1); PG8_STAGE(PG8_SB(1, 0), b3, voffB);
            PG8_BAR; PG8_WAIT_L(0); PG8_MMA(0, 1, At, B1); PG8_BAR;
            PG8_LDA(At, 1, 1); PG8_STAGE(PG8_SA(1, 0), a3, voffA);
            PG8_BAR; PG8_WAIT_L(0); PG8_MMA(1, 0, At, B0); PG8_BAR; PG8_SCHED;
            PG8_STAGE(PG8_SB(1, 1), b3 + hstepB, voffB);
            PG8_WAIT_V(6); PG8_BAR; PG8_MMA(1, 1, At, B1); PG8_BAR;
            }
        }
        if constexpr (ALIGN_EPI) { if (wr == 0) PG8_BAR; }
        if constexpr (!Epi::AFTER_DRAIN) { if constexpr (Epi::HAS_PRE) E(acc, cur, wr, wc, fr, fq, pre); else E(acc, cur, wr, wc, fr, fq); S.done(cur); }
        if constexpr (Epi::HAS_PRE) { if (has_next) E.prefetch(nxt, wr, wc, fr, fq, pre); }
        if (!has_next) break;
#pragma unroll
        for (int a = 0; a < 2; ++a)
#pragma unroll
            for (int b = 0; b < 2; ++b)
#pragma unroll
                for (int m = 0; m < 4; ++m)
#pragma unroll
                    for (int n = 0; n < 2; ++n) acc[a][b][m][n] = (f32x4){0.f, 0.f, 0.f, 0.f};
        cur = nxt; cA = nA; cB = nB; ++ui;
        if constexpr (ALIGN_EPI) { if (wr == 1) PG8_BAR; }
    }
    u32x4 pbv[2][4][2];
    if constexpr (Epi::AFTER_DRAIN) E.preload(cur, wr, wc, fr, fq, pbv);
    PG8_WAIT_V(0);
    if constexpr (!ALIGN_EPI) { if (wr == 0) PG8_BAR; }
    PG8_BAR;
    if constexpr (Epi::AFTER_DRAIN) { E.fused(acc, cur, wr, wc, fr, fq, lds, wid, lane, pbv); S.done(cur); }
#undef PG8_SA
#undef PG8_SB
#undef PG8_STAGE
#undef PG8_LDA
#undef PG8_LDB
#undef PG8_MMA
#undef PG8_WAIT_V
#undef PG8_WAIT_L
#undef PG8_BAR
#undef PG8_SCHED
}
}
#define LAS __attribute__((address_space(3)))
typedef unsigned short bf16;
typedef unsigned v4u __attribute__((ext_vector_type(4)));
typedef unsigned v2u __attribute__((ext_vector_type(2)));
typedef float f32x4 __attribute__((ext_vector_type(4)));
typedef float f32x2 __attribute__((ext_vector_type(2)));
typedef short bf16x8 __attribute__((ext_vector_type(8)));

constexpr int NWAVES = 8;
constexpr int M = 16384, D = 1024, DIN = 1536, LW = 512, FF = 2816, N13 = 2 * FF, SEQ = 8192, TC = 64, NCHUNK = M / TC;
constexpr float EPS = 1e-6f;
constexpr size_t MiB = 1u << 20;
constexpr size_t WS_SS1 = 0, WS_SS2 = 65536, WS_BAR = 131072, WS_CNT = WS_BAR + 16384, WS_SB = WS_BAR + 32768, BAR_BYTES = 32768 + 8192, WS_AGG = 1 * MiB;
constexpr size_t WS_WIN = 2 * MiB, WS_WOUT = 5 * MiB, WS_W13 = 7 * MiB, WS_W2 = 18 * MiB, WS_WGA = 24 * MiB, WS_WGX = WS_WGA + 65536, WS_WP = WS_WGA + 131072;
constexpr size_t WS_XN = 32 * MiB;
constexpr size_t WS_H1B = 64 * MiB;
constexpr size_t WS_U = 96 * MiB;
constexpr size_t WS_H = 144 * MiB;
constexpr size_t WS_END = 232 * MiB;
constexpr int RING_BYTES = 131072, TSTR = 1040, PT_OFF = 64 * TSTR  , SS_OFF = PT_OFF + 79 * TSTR  , CARRY_OFF = SS_OFF + 2048, LDS_BYTES = 155648, MISC_OFF = LDS_BYTES - 128;

#define LDS_WAIT() asm volatile("s_waitcnt lgkmcnt(0)" ::: "memory")
__device__ __forceinline__ float bf_lo(unsigned w) { return __uint_as_float(w << 16); }
__device__ __forceinline__ float bf_hi(unsigned w) { return __uint_as_float(w & 0xffff0000u); }
__device__ __forceinline__ float bf_s(unsigned short h) { return __uint_as_float(((unsigned)h) << 16); }
__device__ __forceinline__ unsigned pk2(float lo, float hi) { return pg8::cvt_pk_bf16(lo, hi); }
__device__ __forceinline__ void unpack8(const v4u v, float (&c)[8]) { c[0] = bf_lo(v.x); c[1] = bf_hi(v.x); c[2] = bf_lo(v.y); c[3] = bf_hi(v.y); c[4] = bf_lo(v.z); c[5] = bf_hi(v.z); c[6] = bf_lo(v.w); c[7] = bf_hi(v.w); }
__device__ __forceinline__ float sigmoid_(float x) { return __builtin_amdgcn_rcpf(1.0f + __expf(-x)); }
__device__ __forceinline__ float nexpm1(float x) {
    const float p = x * (1.0f + x * (0.5f + x * (0.16666667f + x * (0.041666668f + x * (0.0083333338f + x * (0.0013888889f + x * 0.0001984127f))))));
    const float e = 1.0f - __expf(x);
    return x > -0.25f ? -p : e;
}
__device__ __forceinline__ float one_minus_a2(float la, float a) {
    (void)la; return 1.0f - a * a;
}
__device__ __forceinline__ float wave_sum(float v) {
#pragma unroll
    for (int o = 1; o < 64; o <<= 1) v += __shfl_xor(v, o);
    return v;
}

struct TItem { const float* W; bf16* WT; const float* kscale; int N, ldt, k0, n0, drow0; };
__device__ __forceinline__ void t_load(const TItem& it, int lane, f32x4 (&t)[8]) {
#pragma unroll
    for (int i = 0; i < 8; ++i) t[i] = *(const f32x4*)(it.W + (size_t)(it.k0 + 8 * i + (lane >> 3)) * it.N + it.n0 + 4 * (lane & 7));
}
__device__ __forceinline__ void t_proc(const TItem& it, const f32x4 (&t)[8], LAS float* scr, int lane) {
#pragma unroll
    for (int i = 0; i < 8; ++i) { LAS float* d = scr + (8 * i + (lane >> 3)) * 33 + 4 * (lane & 7); d[0] = t[i][0]; d[1] = t[i][1]; d[2] = t[i][2]; d[3] = t[i][3]; }
    LDS_WAIT(); asm volatile("" ::: "memory");
    const int c = lane & 7;
    float ks[8];
#pragma unroll
    for (int i = 0; i < 8; ++i) ks[i] = it.kscale ? it.kscale[it.k0 + 8 * c + i] : 1.0f;
#pragma unroll
    for (int j = 0; j < 4; ++j) { const int n = (lane >> 3) + 8 * j; const LAS float* sp = scr + (8 * c) * 33 + n;
        v4u o; o.x = pk2(sp[0 * 33] * ks[0], sp[1 * 33] * ks[1]); o.y = pk2(sp[2 * 33] * ks[2], sp[3 * 33] * ks[3]); o.z = pk2(sp[4 * 33] * ks[4], sp[5 * 33] * ks[5]); o.w = pk2(sp[6 * 33] * ks[6], sp[7 * 33] * ks[7]);
        *(v4u*)(it.WT + (size_t)(it.drow0 + n) * it.ldt + it.k0 + 8 * c) = o; }
    LDS_WAIT(); asm volatile("" ::: "memory");
}
#define T_RUN(first, stride, n, DEC, scr, lane) do { int it_ = (first); if (it_ < (n)) { TItem cur_; f32x4 ta_[8]; DEC(it_, cur_); t_load(cur_, (lane), ta_); \
        for (;;) { const int nx_ = it_ + (stride); const bool has_ = nx_ < (n); TItem nxt_ = cur_; f32x4 tb_[8]; if (has_) { DEC(nx_, nxt_); t_load(nxt_, (lane), tb_); } \
            t_proc(cur_, ta_, (scr), (lane)); if (!has_) break; cur_ = nxt_; _Pragma("unroll") for (int q_ = 0; q_ < 8; ++q_) ta_[q_] = tb_[q_]; it_ = nx_; } } } while (0)

struct BTile { const float* W; bf16* WT; const float* kscale; int N, ldt, k0, n0, mode; };
__device__ __forceinline__ void bt_load(const BTile& t, int wave, int lane, f32x4 (&r)[8], f32x4 (&ksv)[2]) {
    if (t.kscale) { ksv[0] = *(const f32x4*)(t.kscale + t.k0 + 8 * (lane & 7)); ksv[1] = *(const f32x4*)(t.kscale + t.k0 + 8 * (lane & 7) + 4); }
    else { ksv[0] = (f32x4){1.f, 1.f, 1.f, 1.f}; ksv[1] = ksv[0]; }
#pragma unroll
    for (int i = 0; i < 8; ++i) r[i] = *(const f32x4*)(t.W + (size_t)(t.k0 + 8 * wave + i) * t.N + t.n0 + 4 * lane);
}
__device__ __forceinline__ void bt_proc(const BTile& t, const f32x4 (&r)[8], const f32x4 (&ksv)[2], LAS float* tile  , int wave, int lane) {
    const int c = lane & 7, nr = lane >> 3;
    const float ks[8] = {ksv[0][0], ksv[0][1], ksv[0][2], ksv[0][3], ksv[1][0], ksv[1][1], ksv[1][2], ksv[1][3]};
#pragma unroll
    for (int i = 0; i < 8; ++i) { LAS float* d = tile + (8 * wave + i) * 257 + 4 * lane; d[0] = r[i][0]; d[1] = r[i][1]; d[2] = r[i][2]; d[3] = r[i][3]; }
    __syncthreads();
#pragma unroll
    for (int j = 0; j < 4; ++j) { const int n = 32 * wave + 8 * j + nr; const LAS float* sp = tile + (8 * c) * 257 + n;
        v4u o; o.x = pk2(sp[0 * 257] * ks[0], sp[1 * 257] * ks[1]); o.y = pk2(sp[2 * 257] * ks[2], sp[3 * 257] * ks[3]); o.z = pk2(sp[4 * 257] * ks[4], sp[5 * 257] * ks[5]); o.w = pk2(sp[6 * 257] * ks[6], sp[7 * 257] * ks[7]);
        const int gn = t.n0 + n, drow = t.mode == 0 ? gn : 256 * (gn >> 7) + (gn & 127) + (t.mode == 2 ? 128 : 0);
        *(v4u*)(t.WT + (size_t)(drow >> 8) * (256 * (size_t)t.ldt) + (size_t)(t.k0 >> 6) * (256 * 64) + (size_t)(drow & 255) * 64 + 8 * c) = o; }
    __syncthreads();
}

#define XB_TMO      128
#define XB_XCNT(j)  (256  + 64 * (j))
#define XB_XSUB(j)  (1280 + 64 * (j))
#define XB_XGEN(j)  (2304 + 64 * (j))
#define XB_TOP      3328
#define XB_TOPGEN   3392
#define XCD_BAR_WORDS 3456
#define XB_SPIN_CAP (1u << 18)

__device__ __forceinline__ unsigned xb_ld(unsigned* p)              { return __hip_atomic_load(p, __ATOMIC_RELAXED, __HIP_MEMORY_SCOPE_AGENT); }
__device__ __forceinline__ unsigned xb_add(unsigned* p, unsigned v) { return __hip_atomic_fetch_add(p, v, __ATOMIC_RELAXED, __HIP_MEMORY_SCOPE_AGENT); }
__device__ __forceinline__ unsigned xb_xcc_id() { return (unsigned)__builtin_amdgcn_s_getreg((3 << 11) | 20) & 0xFu; }
#define XB_SPIN(cond, bar) do { unsigned _sp = 0; while (cond) { __builtin_amdgcn_s_sleep(1); \
    if ((++_sp & 255u) == 0u) { if (xb_ld(&(bar)[XB_TMO])) break; if (_sp > XB_SPIN_CAP) { atomicAdd(&(bar)[XB_TMO], 1u); break; } } } } while (0)

struct XcdBarrier {
    unsigned* bar; unsigned x;
    volatile LAS unsigned* st;
};

__device__ __forceinline__ XcdBarrier xcd_barrier_post(unsigned* bar, volatile LAS unsigned* st) {
    XcdBarrier b; b.bar = bar; b.x = xb_xcc_id(); b.st = st;
    if (threadIdx.x == 0) (void)xb_add(&bar[XB_XCNT(b.x)], 1u);
    return b;
}
__device__ __forceinline__ void xcd_barrier_complete(unsigned* bar, unsigned x, unsigned& nloc, unsigned& nx) {
    const unsigned G = gridDim.x * gridDim.y * gridDim.z;
    unsigned sum, cnt, mine, sp = 0u;
    for (;;) {
        sum = 0u; cnt = 0u; mine = 0u;
#pragma unroll
        for (unsigned j = 0; j < 16; ++j) { const unsigned c = xb_ld(&bar[XB_XCNT(j)]); sum += c; cnt += (c > 0u) ? 1u : 0u; mine = (j == x) ? c : mine; }
        if (sum == G) break;
        __builtin_amdgcn_s_sleep(1);
        if ((++sp & 255u) == 0u) { if (xb_ld(&bar[XB_TMO])) break; if (sp > XB_SPIN_CAP) { atomicAdd(&bar[XB_TMO], 1u); break; } }
    }
    nloc = mine > 0u ? mine : 1u; nx = cnt > 0u ? cnt : 1u;
}

__device__ __forceinline__ void xcd_barrier(const XcdBarrier& b) {
    asm volatile("s_waitcnt vmcnt(0)" ::: "memory");
    __syncthreads();
    if (threadIdx.x == 0) {
        unsigned* bar = b.bar;
        __builtin_amdgcn_s_waitcnt(0);
        unsigned nloc = b.st[0], nx = b.st[1];
        if (nloc == 0u) { xcd_barrier_complete(bar, b.x, nloc, nx); b.st[0] = nloc; b.st[1] = nx; }
        const unsigned old = xb_add(&bar[XB_XSUB(b.x)], 1u);
        const unsigned gen = old / nloc;
        if (old + 1u == (gen + 1u) * nloc) {
            __builtin_amdgcn_fence(__ATOMIC_RELEASE, "agent");
            asm volatile("s_waitcnt vmcnt(0)" ::: "memory");
            const unsigned og = xb_add(&bar[XB_TOP], 1u);
            const unsigned tg = og / nx;
            if (og + 1u == (tg + 1u) * nx) xb_add(&bar[XB_TOPGEN], 1u);
            else XB_SPIN(xb_ld(&bar[XB_TOPGEN]) == tg, bar);
            __builtin_amdgcn_fence(__ATOMIC_ACQUIRE, "agent");
            xb_add(&bar[XB_XGEN(b.x)], 1u);
            asm volatile("s_waitcnt vmcnt(0)" ::: "memory");
        } else {
            XB_SPIN(xb_ld(&bar[XB_XGEN(b.x)]) == gen, bar);
            __builtin_amdgcn_fence(__ATOMIC_ACQUIRE, "agent");
            asm volatile("s_waitcnt vmcnt(0)" ::: "memory");
        }
    }
    __syncthreads();
}

__device__ __forceinline__ void sb_arrive(unsigned* ctr) {
    asm volatile("s_waitcnt vmcnt(0)" ::: "memory");
    __syncthreads();
    if (threadIdx.x == 0) { __builtin_amdgcn_fence(__ATOMIC_RELEASE, "agent"); asm volatile("s_waitcnt vmcnt(0)" ::: "memory"); __hip_atomic_fetch_add(ctr, 1u, __ATOMIC_RELAXED, __HIP_MEMORY_SCOPE_AGENT); }
}
__device__ __forceinline__ void sb_wait(unsigned* ctr, unsigned n) {
    if (threadIdx.x == 0) { unsigned sp = 0;
        while (__hip_atomic_load(ctr, __ATOMIC_RELAXED, __HIP_MEMORY_SCOPE_AGENT) < n) { __builtin_amdgcn_s_sleep(1); if (++sp > (1u << 22)) break; }
        __builtin_amdgcn_fence(__ATOMIC_ACQUIRE, "agent"); asm volatile("s_waitcnt vmcnt(0)" ::: "memory"); }
    __syncthreads();
}
__device__ __forceinline__ void sbx_arrive(unsigned* sub, const XcdBarrier& b) {
    asm volatile("s_waitcnt vmcnt(0)" ::: "memory");
    __syncthreads();
    if (threadIdx.x == 0) { const unsigned nloc = b.st[0];
        const unsigned old = __hip_atomic_fetch_add(sub + 64 * b.x, 1u, __ATOMIC_RELAXED, __HIP_MEMORY_SCOPE_AGENT);
        if (old + 1u == nloc) { __builtin_amdgcn_fence(__ATOMIC_RELEASE, "agent"); asm volatile("s_waitcnt vmcnt(0)" ::: "memory"); __hip_atomic_fetch_add(sub + 64 * 16, 1u, __ATOMIC_RELAXED, __HIP_MEMORY_SCOPE_AGENT); } }
}
__device__ __forceinline__ void sbx_wait(unsigned* sub, const XcdBarrier& b) {
    if (threadIdx.x == 0) { const unsigned nx = b.st[1]; unsigned sp = 0;
        while (__hip_atomic_load(sub + 64 * 16, __ATOMIC_RELAXED, __HIP_MEMORY_SCOPE_AGENT) < nx) { __builtin_amdgcn_s_sleep(1); if (++sp > (1u << 22)) break; }
        __builtin_amdgcn_fence(__ATOMIC_ACQUIRE, "agent"); asm volatile("s_waitcnt vmcnt(0)" ::: "memory"); }
    __syncthreads();
}
struct Args { const float* in[21]; float* out; unsigned char* ws; };

__global__ void __launch_bounds__(NWAVES * 64, 2) fwd_mega(Args args) {
    extern __shared__ __attribute__((aligned(16))) unsigned char lds_raw[];
    LAS unsigned char* lds = (LAS unsigned char*)lds_raw;
    cg::grid_group grid = cg::this_grid();
    if (args.ws == nullptr) grid.sync();
    { volatile LAS unsigned* misc = (volatile LAS unsigned*)((LAS unsigned char*)lds_raw + MISC_OFF); if (threadIdx.x < 32) misc[threadIdx.x] = 0u; }
    __syncthreads();
    const XcdBarrier gbar = xcd_barrier_post((unsigned*)(args.ws + WS_BAR), (volatile LAS unsigned*)((LAS unsigned char*)lds_raw + MISC_OFF) + 8);
#define GRID_SYNC() xcd_barrier(gbar)
    const int tid = threadIdx.x, lane = tid & 63, wave = __builtin_amdgcn_readfirstlane(tid >> 6);
    const int G = gridDim.x, bx = blockIdx.x;
    unsigned char* ws = args.ws;
    const float* x = args.in[0]; float* out = args.out;
    float* rowss1 = (float*)(ws + WS_SS1); float* rowss2 = (float*)(ws + WS_SS2); f32x2* agg = (f32x2*)(ws + WS_AGG);
    bf16* Win_t = (bf16*)(ws + WS_WIN); bf16* Wout_t = (bf16*)(ws + WS_WOUT); bf16* W13_t = (bf16*)(ws + WS_W13); bf16* W2_t = (bf16*)(ws + WS_W2);
    bf16* WGA_t = (bf16*)(ws + WS_WGA); bf16* WGX_t = (bf16*)(ws + WS_WGX); bf16* WP_t = (bf16*)(ws + WS_WP);
    bf16* XN = (bf16*)(ws + WS_XN); bf16* Y = XN; bf16* H1B = (bf16*)(ws + WS_H1B); bf16* U = (bf16*)(ws + WS_U); bf16* HB = (bf16*)(ws + WS_H);

    {
        const int gw = bx * NWAVES + wave, NGW = G * NWAVES;
        for (int i = bx * (NWAVES * 64) + tid; i < 2 * M; i += G * NWAVES * 64) rowss1[i] = 0.f;
        LAS float* scr = (LAS float*)(lds + wave * 16384);
        constexpr int I_IN = (D / 64) * (DIN / 32), I_G = 16, I_P = 32;
        constexpr int NITEMS = I_IN + 2 * I_G + I_P;
#define DEC_P0(r_, T_) do { int r = (r_); \
            if (r < I_IN) { const int nb = r % (DIN / 32), kb = r / (DIN / 32); T_ = TItem{args.in[2], Win_t, nullptr, DIN, D, 64 * kb, 32 * nb, 32 * nb}; } \
            else if ((r -= I_IN) < I_G) { const int hh = r >> 1, nb = r & 1; T_ = TItem{args.in[5] + hh * 4096, WGA_t + hh * 4096, nullptr, 64, 64, 0, 32 * nb, 32 * nb}; } \
            else if ((r -= I_G) < I_G) { const int hh = r >> 1, nb = r & 1; T_ = TItem{args.in[7] + hh * 4096, WGX_t + hh * 4096, nullptr, 64, 64, 0, 32 * nb, 32 * nb}; } \
            else { r -= I_G; const int gg = r >> 3, q8 = r & 7, kb = q8 >> 2, nb = q8 & 3; T_ = TItem{args.in[10] + gg * 16384, WP_t + gg * 16384, nullptr, 128, 128, 64 * kb, 32 * nb, 32 * nb}; } } while (0)
        T_RUN(gw, NGW, NITEMS, DEC_P0, scr, lane);
#undef DEC_P0
        const f32x4* gp = (const f32x4*)args.in[1] + lane;
        f32x4 gv[4];
#pragma unroll
        for (int j = 0; j < 4; ++j) gv[j] = gp[64 * j];
        constexpr int NGRP = M / 4;
        const int vb = (G == 256) ? ((bx & 7) * 32 + (bx >> 3)) : bx;
        for (int pass = 0; pass < 2; ++pass) {
            const int grp = 16 * vb + 8 * pass + wave; if (grp >= NGRP) break;
            const int m0 = grp * 4;
            f32x4 v[4][4]; float sq[4];
#pragma unroll
            for (int r = 0; r < 4; ++r) { const f32x4* xr = (const f32x4*)(x + (size_t)(m0 + r) * D) + lane;
#pragma unroll
                for (int j = 0; j < 4; ++j) v[r][j] = xr[64 * j]; }
#pragma unroll
            for (int r = 0; r < 4; ++r) { float s2 = 0.f;
#pragma unroll
                for (int j = 0; j < 4; ++j) { const f32x4 vv = v[r][j] * v[r][j]; s2 += (vv.x + vv.y) + (vv.z + vv.w); }
                sq[r] = s2; }
#pragma unroll
            for (int o = 1; o < 64; o <<= 1) {
#pragma unroll
                for (int r = 0; r < 4; ++r) sq[r] += __shfl_xor(sq[r], o); }
#pragma unroll
            for (int r = 0; r < 4; ++r) { const float rstd = __builtin_amdgcn_rsqf(sq[r] * (1.0f / D) + EPS);
                unsigned long long* o8 = (unsigned long long*)(XN + (size_t)(m0 + r) * D) + lane;
#pragma unroll
                for (int j = 0; j < 4; ++j) { const f32x4 y = v[r][j] * rstd * gv[j]; o8[64 * j] = (unsigned long long)pk2(y.x, y.y) | ((unsigned long long)pk2(y.z, y.w) << 32); } }
        }
    }
    GRID_SYNC();

    {
        pg8::Gemm g{XN, Win_t, M, DIN, D, 0}; pg8::RotOrder<2> S; S.init(M, DIN, G, bx);
        pg8::EpiU E{U, DIN};
        pg8::gemm_phase<pg8::EpiU, pg8::RotOrder<2>, true, true>(lds, g, S, E);
        if (bx >= 128) {
            int lane_d; asm volatile("v_and_b32 %0, 63, %1" : "=v"(lane_d) : "v"(threadIdx.x));
            LAS float* tile = (LAS float*)lds;
            constexpr int T_OUT = (D / 64) * (D / 256), T_1 = (D / 64) * (FF / 256), T_2 = (FF / 64) * (D / 256), NT = T_OUT + 2 * T_1 + T_2;
#define DEC_BT(r_, T_) do { int r = (r_); \
                if (r < T_OUT) { const int nb = r % (D / 256), kb = r / (D / 256); T_ = BTile{args.in[15], Wout_t, (64 * kb < LW) ? args.in[13] : args.in[14] - LW, D, D, 64 * kb, 256 * nb, 0}; } \
                else if ((r -= T_OUT) < T_1) { const int nb = r % (FF / 256), kb = r / (FF / 256); T_ = BTile{args.in[17], W13_t, args.in[16], FF, D, 64 * kb, 256 * nb, 1}; } \
                else if ((r -= T_1) < T_1) { const int nb = r % (FF / 256), kb = r / (FF / 256); T_ = BTile{args.in[18], W13_t, args.in[16], FF, D, 64 * kb, 256 * nb, 2}; } \
                else { r -= T_1; const int nb = r % (D / 256), kb = r / (D / 256); T_ = BTile{args.in[19], W2_t, nullptr, D, FF, 64 * kb, 256 * nb, 0}; } } while (0)
            { int it = bx - 128; BTile cur; f32x4 ta[8], ka[2]; DEC_BT(it, cur); bt_load(cur, wave, lane_d, ta, ka);
              for (;;) { const int nx = it + 128; const bool has = nx < NT; BTile nxt = cur; f32x4 tb[8], kb2[2]; if (has) { DEC_BT(nx, nxt); bt_load(nxt, wave, lane_d, tb, kb2); }
                  bt_proc(cur, ta, ka, tile, wave, lane_d); if (!has) break; cur = nxt;
#pragma unroll
                  for (int q_ = 0; q_ < 8; ++q_) ta[q_] = tb[q_];
                  ka[0] = kb2[0]; ka[1] = kb2[1];
                  it = nx; } }
#undef DEC_BT
        }
    }
    GRID_SYNC();

    {
        int tid_l; asm volatile("v_mov_b32 %0, %1" : "=v"(tid_l) : "v"(threadIdx.x));
        const int tid = tid_l, lane = tid & 63;
        const int ci = (G == 256) ? ((bx & 7) * 32 + (bx >> 3)) : bx;
        const int b = ci >> 7, c = ci & 127, t0 = c * TC, grow0 = b * SEQ + t0;
        const int q = lane >> 4, c15 = lane & 15;
        LAS unsigned char* T = lds;
        LAS unsigned char* PT = lds + PT_OFF;
        LAS float* SS = (LAS float*)(lds + SS_OFF);
        LAS float* CARRY = (LAS float*)(lds + CARRY_OFF);
        const bf16* Ub = U + (size_t)(b * SEQ) * DIN;
        const v4u vz = (v4u){0u, 0u, 0u, 0u};
        v4u cvr[11];
        {
            v4u pv[10];
#pragma unroll
            for (int i = 0; i < 10; ++i) { const int p = tid + 512 * i, r = p >> 6, c16 = p & 63, t = t0 - 15 + r;
                pv[i] = (r < 79 && t >= 0) ? *(const v4u*)(Ub + (size_t)(t < 0 ? 0 : t) * DIN + 1024 + c16 * 8) : vz; }
            { const int tb = t0 + 8 * wave; const bf16* ul = Ub + lane * 8;
#pragma unroll
              for (int i = 0; i < 11; ++i) { const int t = tb - 3 + i; cvr[i] = (t >= 0) ? *(const v4u*)(ul + (size_t)(t < 0 ? 0 : t) * DIN) : vz; } }
#pragma unroll
            for (int i = 0; i < 10; ++i) { const int p = tid + 512 * i, r = p >> 6, c16 = p & 63; if (r < 79) *(LAS v4u*)(PT + r * TSTR + c16 * 16) = pv[i]; }
        }
        float hl[4][4][4]; unsigned ppk[4][4][2];
        {
        {
            const int ch0 = lane * 8;
            f32x2 cw[4][4], cb[4];
#pragma unroll
            for (int k = 0; k < 4; ++k) { const f32x4 w0 = *(const f32x4*)(args.in[3] + k * LW + ch0), w1 = *(const f32x4*)(args.in[3] + k * LW + ch0 + 4);
                cw[k][0] = (f32x2){w0[0], w0[1]}; cw[k][1] = (f32x2){w0[2], w0[3]}; cw[k][2] = (f32x2){w1[0], w1[1]}; cw[k][3] = (f32x2){w1[2], w1[3]}; }
            { const f32x4 w0 = *(const f32x4*)(args.in[4] + ch0), w1 = *(const f32x4*)(args.in[4] + ch0 + 4); cb[0] = (f32x2){w0[0], w0[1]}; cb[1] = (f32x2){w0[2], w0[3]}; cb[2] = (f32x2){w1[0], w1[1]}; cb[3] = (f32x2){w1[2], w1[3]}; }
            f32x2 r0[4], r1[4], r2[4];
#define P2_UNPK(v, dst) do { dst[0] = (f32x2){bf_lo((v).x), bf_hi((v).x)}; dst[1] = (f32x2){bf_lo((v).y), bf_hi((v).y)}; dst[2] = (f32x2){bf_lo((v).z), bf_hi((v).z)}; dst[3] = (f32x2){bf_lo((v).w), bf_hi((v).w)}; } while (0)
            P2_UNPK(cvr[0], r0); P2_UNPK(cvr[1], r1); P2_UNPK(cvr[2], r2);
#pragma unroll
            for (int i = 0; i < 8; ++i) { f32x2 cv[4], xc[4]; P2_UNPK(cvr[3 + i], cv);
#pragma unroll
                for (int j = 0; j < 4; ++j) { xc[j] = cb[j] + cw[0][j] * r0[j] + cw[1][j] * r1[j] + cw[2][j] * r2[j] + cw[3][j] * cv[j]; r0[j] = r1[j]; r1[j] = r2[j]; r2[j] = cv[j]; }
                v4u o; o.x = pk2(xc[0].x, xc[0].y); o.y = pk2(xc[1].x, xc[1].y); o.z = pk2(xc[2].x, xc[2].y); o.w = pk2(xc[3].x, xc[3].y);
                *(LAS v4u*)(T + (8 * wave + i) * TSTR + ch0 * 2) = o; }
#undef P2_UNPK
        }
        __syncthreads();
        {
            const int h = wave;
            const int sa16 = ((lane - 16) & 63) * 4, sa32 = ((lane - 32) & 63) * 4, sa48 = (48 + c15) * 4;
#define P2_BP(addr, v) __int_as_float(__builtin_amdgcn_ds_bpermute((addr), __float_as_int(v)))
#pragma unroll
            for (int ctp = 0; ctp < 2; ++ctp) {
                asm volatile("" ::: "memory");
                bf16x8 fa[2][2], fx[2][2]; float bav[2], bxv[2], sp8[2], Pc[2], Hc[2]; int ch[2];
#pragma unroll
                for (int e = 0; e < 2; ++e) { const int ct = 2 * ctp + e; ch[e] = h * 64 + ct * 16 + c15;
                    const bf16* wa_ = WGA_t + h * 4096 + (ct * 16 + c15) * 64 + 8 * q; const bf16* wx_ = WGX_t + h * 4096 + (ct * 16 + c15) * 64 + 8 * q;
                    fa[e][0] = *(const bf16x8*)wa_; fa[e][1] = *(const bf16x8*)(wa_ + 32); fx[e][0] = *(const bf16x8*)wx_; fx[e][1] = *(const bf16x8*)(wx_ + 32);
                    bav[e] = args.in[6][ch[e]]; bxv[e] = args.in[8][ch[e]]; const float lam = args.in[9][ch[e]];
                    sp8[e] = 8.0f * (fmaxf(-lam, 0.f) + log1pf(__expf(-fabsf(lam)))); Pc[e] = 1.f; Hc[e] = 0.f; }
#pragma unroll
                for (int rt = 0; rt < 4; ++rt) {
                    asm volatile("" ::: "memory");
                    const LAS unsigned char* ap = T + (rt * 16 + c15) * TSTR + (h * 64 + 8 * q) * 2;
                    const bf16x8 a0 = *(const LAS bf16x8*)ap, a1 = *(const LAS bf16x8*)(ap + 64);
                    f32x4 ar[2], ai[2]; float P[2][4], H[2][4], Pi[2], Hi[2], Pe[2], He[2], Pt[2], Ht[2];
#pragma unroll
                    for (int e = 0; e < 2; ++e) { ar[e] = (f32x4){0.f, 0.f, 0.f, 0.f}; ai[e] = (f32x4){0.f, 0.f, 0.f, 0.f};
                        ar[e] = __builtin_amdgcn_mfma_f32_16x16x32_bf16(a0, fa[e][0], ar[e], 0, 0, 0); ai[e] = __builtin_amdgcn_mfma_f32_16x16x32_bf16(a0, fx[e][0], ai[e], 0, 0, 0); }
#pragma unroll
                    for (int e = 0; e < 2; ++e) { ar[e] = __builtin_amdgcn_mfma_f32_16x16x32_bf16(a1, fa[e][1], ar[e], 0, 0, 0); ai[e] = __builtin_amdgcn_mfma_f32_16x16x32_bf16(a1, fx[e][1], ai[e], 0, 0, 0); }
#pragma unroll
                    for (int e = 0; e < 2; ++e) {
                        float av[4], bbv[4];
                        const f32x2 nl2 = (f32x2){-1.44269504f, -1.44269504f}, one2 = (f32x2){1.0f, 1.0f};
                        const f32x2 bav2 = (f32x2){bav[e], bav[e]}, bxv2 = (f32x2){bxv[e], bxv[e]}, nsl2 = (f32x2){-sp8[e] * 1.44269504f, -sp8[e] * 1.44269504f};
#pragma unroll
                        for (int jp = 0; jp < 2; ++jp) { const int tl = rt * 16 + 4 * q + 2 * jp;
                            const f32x2 xcv = (f32x2){bf_s(*(const LAS unsigned short*)(T + tl * TSTR + ch[e] * 2)), bf_s(*(const LAS unsigned short*)(T + (tl + 1) * TSTR + ch[e] * 2))};
                            const f32x2 tr = ((f32x2){ar[e][2 * jp], ar[e][2 * jp + 1]} + bav2) * nl2, ti = ((f32x2){ai[e][2 * jp], ai[e][2 * jp + 1]} + bxv2) * nl2;
                            f32x2 er, ei; er.x = __builtin_amdgcn_exp2f(tr.x); er.y = __builtin_amdgcn_exp2f(tr.y); ei.x = __builtin_amdgcn_exp2f(ti.x); ei.y = __builtin_amdgcn_exp2f(ti.y);
                            const f32x2 dr = er + one2, di = ei + one2;
                            f32x2 r, ig; r.x = __builtin_amdgcn_rcpf(dr.x); r.y = __builtin_amdgcn_rcpf(dr.y); ig.x = __builtin_amdgcn_rcpf(di.x); ig.y = __builtin_amdgcn_rcpf(di.y);
                            const f32x2 la2 = r * nsl2;
                            f32x2 a; a.x = __builtin_amdgcn_exp2f(la2.x); a.y = __builtin_amdgcn_exp2f(la2.y);
                            const f32x2 om = one2 - a * a;
                            f32x2 mult; mult.x = __builtin_amdgcn_sqrtf(fmaxf(om.x, 1e-12f)); mult.y = __builtin_amdgcn_sqrtf(fmaxf(om.y, 1e-12f));
                            const f32x2 bb = (mult * ig) * xcv;
                            av[2 * jp] = a.x; av[2 * jp + 1] = a.y; bbv[2 * jp] = bb.x; bbv[2 * jp + 1] = bb.y; }
                        P[e][0] = av[0]; H[e][0] = bbv[0];
#pragma unroll
                        for (int j = 1; j < 4; ++j) { P[e][j] = av[j] * P[e][j - 1]; H[e][j] = av[j] * H[e][j - 1] + bbv[j]; } }
#pragma unroll
                    for (int e = 0; e < 2; ++e) { Pi[e] = P[e][3]; Hi[e] = H[e][3]; }
                    { float Pp[2], Hp[2];
#pragma unroll
                      for (int e = 0; e < 2; ++e) { Pp[e] = P2_BP(sa16, Pi[e]); Hp[e] = P2_BP(sa16, Hi[e]); }
#pragma unroll
                      for (int e = 0; e < 2; ++e) if (q >= 1) { Hi[e] = Pi[e] * Hp[e] + Hi[e]; Pi[e] = Pp[e] * Pi[e]; } }
                    { float Pp[2], Hp[2];
#pragma unroll
                      for (int e = 0; e < 2; ++e) { Pp[e] = P2_BP(sa32, Pi[e]); Hp[e] = P2_BP(sa32, Hi[e]); }
#pragma unroll
                      for (int e = 0; e < 2; ++e) if (q >= 2) { Hi[e] = Pi[e] * Hp[e] + Hi[e]; Pi[e] = Pp[e] * Pi[e]; } }
#pragma unroll
                    for (int e = 0; e < 2; ++e) { Pe[e] = P2_BP(sa16, Pi[e]); He[e] = P2_BP(sa16, Hi[e]); Pt[e] = P2_BP(sa48, Pi[e]); Ht[e] = P2_BP(sa48, Hi[e]); }
#pragma unroll
                    for (int e = 0; e < 2; ++e) { const int ct = 2 * ctp + e; if (q == 0) { Pe[e] = 1.f; He[e] = 0.f; }
                        const float Ppre = Pc[e] * Pe[e], Hpre = Pe[e] * Hc[e] + He[e];
#pragma unroll
                        for (int j = 0; j < 4; ++j) hl[ct][rt][j] = H[e][j] + P[e][j] * Hpre;
                        ppk[ct][rt][0] = pk2(P[e][0] * Ppre, P[e][1] * Ppre); ppk[ct][rt][1] = pk2(P[e][2] * Ppre, P[e][3] * Ppre);
                        asm volatile("" : "+v"(hl[ct][rt][0]), "+v"(hl[ct][rt][1]), "+v"(hl[ct][rt][2]), "+v"(hl[ct][rt][3]), "+v"(ppk[ct][rt][0]), "+v"(ppk[ct][rt][1]));
                        Hc[e] = Pt[e] * Hc[e] + Ht[e]; Pc[e] = Pc[e] * Pt[e]; }
                }
#pragma unroll
                for (int e = 0; e < 2; ++e) if (q == 0) agg[(size_t)ci * LW + ch[e]] = (f32x2){Pc[e], Hc[e]};
            }
#undef P2_BP
        }
        }
        sbx_arrive((unsigned*)(ws + WS_SB), gbar);
        {
            const int g = wave >> 1, th = wave & 1, ts = q, win = 2 << g, nh = th;
            const bf16* wp = WP_t + g * 16384 + (size_t)(nh * 64 + c15) * 128 + 8 * q;
            const int tl0 = th * 32 + ts * 8, tfirst = t0 + tl0;
            const LAS unsigned char* pp0 = PT + (tl0 + 15) * TSTR + (g * 128 + c15 * 8) * 2;
#define P2_UNPK4(v, dst) do { dst[0] = (f32x2){bf_lo((v).x), bf_hi((v).x)}; dst[1] = (f32x2){bf_lo((v).y), bf_hi((v).y)}; dst[2] = (f32x2){bf_lo((v).z), bf_hi((v).z)}; dst[3] = (f32x2){bf_lo((v).w), bf_hi((v).w)}; } while (0)
            f32x2 s[4];
#pragma unroll
            for (int j = 0; j < 4; ++j) s[j] = (f32x2){0.f, 0.f};
            for (int k = 1; k < win; ++k) { f32x2 cv[4]; const v4u lv = *(const LAS v4u*)(pp0 - k * TSTR); P2_UNPK4(lv, cv);
#pragma unroll
                for (int j = 0; j < 4; ++j) s[j] += cv[j]; }
#pragma unroll
            for (int i = 0; i < 8; ++i) { const int t = tfirst + i; f32x2 cv[4]; const v4u lv = *(const LAS v4u*)(pp0 + i * TSTR); P2_UNPK4(lv, cv);
                const float inv = 1.0f / (float)(t + 1 < win ? t + 1 : win); const f32x2 inv2 = (f32x2){inv, inv}; f32x2 p[4];
#pragma unroll
                for (int j = 0; j < 4; ++j) { s[j] += cv[j]; p[j] = s[j] * inv2 - cv[j]; }
                v4u o; o.x = pk2(p[0].x, p[0].y); o.y = pk2(p[1].x, p[1].y); o.z = pk2(p[2].x, p[2].y); o.w = pk2(p[3].x, p[3].y);
                *(LAS v4u*)(T + (tl0 + i) * TSTR + (g * 128 + c15 * 8) * 2) = o;
                f32x2 ov[4]; const v4u lo_ = *(const LAS v4u*)(pp0 + (i - win + 1) * TSTR); P2_UNPK4(lo_, ov);
#pragma unroll
                for (int j = 0; j < 4; ++j) s[j] -= ov[j]; }
#undef P2_UNPK4
            __syncthreads();
            f32x4 acc[4][4];
#pragma unroll
            for (int rt = 0; rt < 4; ++rt)
#pragma unroll
                for (int ct = 0; ct < 4; ++ct) acc[rt][ct] = (f32x4){0.f, 0.f, 0.f, 0.f};
            bf16x8 bfr[2][4];
#pragma unroll
            for (int ks = 0; ks < 4; ++ks) bfr[0][ks] = *(const bf16x8*)(wp + ks * 32);
#pragma unroll
            for (int ct = 0; ct < 4; ++ct) {
                asm volatile("" ::: "memory");
                if (ct < 3) {
#pragma unroll
                    for (int ks = 0; ks < 4; ++ks) bfr[(ct + 1) & 1][ks] = *(const bf16x8*)(wp + (ct + 1) * 2048 + ks * 32); }
#pragma unroll
                for (int rt = 0; rt < 4; ++rt)
#pragma unroll
                    for (int ks = 0; ks < 4; ++ks) { const bf16x8 a = *(const LAS bf16x8*)(T + (rt * 16 + c15) * TSTR + (g * 128 + ks * 32 + 8 * q) * 2);
                        acc[rt][ct] = __builtin_amdgcn_mfma_f32_16x16x32_bf16(bfr[ct & 1][ks], a, acc[rt][ct], 0, 0, 0); } }
            const int pc0 = g * 128 + nh * 64 + 4 * q;
            float ssq[4] = {0.f, 0.f, 0.f, 0.f};
#pragma unroll
            for (int ct = 0; ct < 4; ++ct) { const f32x4 pb = *(const f32x4*)(args.in[11] + pc0 + ct * 16), psc = *(const f32x4*)(args.in[12] + pc0 + ct * 16);
#pragma unroll
                for (int rt = 0; rt < 4; ++rt) { const f32x4 y = (acc[rt][ct] + pb) * psc; acc[rt][ct] = y; const f32x4 y2 = y * y; ssq[rt] += (y2[0] + y2[1]) + (y2[2] + y2[3]); } }
#pragma unroll
            for (int rt = 0; rt < 4; ++rt) { float v = ssq[rt]; v += __shfl_xor(v, 16); v += __shfl_xor(v, 32); if (q == 0) SS[(rt * 16 + c15) * 8 + wave] = v; }
            __syncthreads();
            float rstd[4];
#pragma unroll
            for (int rt = 0; rt < 4; ++rt) { const f32x4 s0 = *(const LAS f32x4*)(SS + (rt * 16 + c15) * 8), s1 = *(const LAS f32x4*)(SS + (rt * 16 + c15) * 8 + 4);
                rstd[rt] = __builtin_amdgcn_rsqf(((s0[0] + s0[1]) + (s0[2] + s0[3]) + (s1[0] + s1[1]) + (s1[2] + s1[3])) * (1.0f / 512.0f) + EPS); }
#pragma unroll
            for (int ct = 0; ct < 4; ++ct) {
#pragma unroll
                for (int rt = 0; rt < 4; ++rt) { const f32x4 y = acc[rt][ct] * rstd[rt]; v2u o; o.x = pk2(y[0], y[1]); o.y = pk2(y[2], y[3]);
                    *(LAS v2u*)(T + (rt * 16 + c15) * TSTR + (pc0 + ct * 16) * 2) = o; } }
            __syncthreads();
#pragma unroll
            for (int i = 0; i < 8; ++i) { const int p = tid + 512 * i, row = p >> 6, c16 = p & 63; const v4u v = *(const LAS v4u*)(T + row * TSTR + c16 * 16);
                pg8::st16(Y + (size_t)(grow0 + row) * D + 512 + c16 * 8, v); }
            __syncthreads();
        }
        sbx_wait((unsigned*)(ws + WS_SB), gbar);
        {
            const int h = wave;
            int tid_b; asm volatile("v_mov_b32 %0, %1" : "=v"(tid_b) : "v"(threadIdx.x));
            const int tid = tid_b, lane = tid & 63, q = lane >> 4, c15 = lane & 15;
            {
                LAS f32x2* SEG = (LAS f32x2*)PT;
                const f32x4* ag4 = (const f32x4*)(agg + (size_t)(b * 128) * LW) + lane;
#pragma unroll 1
                for (int kq = 0; kq < 4; ++kq) {
                    f32x4 v[16];
#pragma unroll
                    for (int i = 0; i < 16; ++i) { const int rw = 16 * wave + i, rc = rw < c ? rw : (c > 0 ? c - 1 : 0); v[i] = ag4[(size_t)rc * (LW / 2) + kq * 64]; }
                    f32x2 AA = (f32x2){1.f, 1.f}, BB = (f32x2){0.f, 0.f};
#pragma unroll
                    for (int i = 0; i < 16; ++i) { const bool on = (16 * wave + i) < c; const f32x2 a2 = on ? (f32x2){v[i][0], v[i][2]} : (f32x2){1.f, 1.f}, b2 = on ? (f32x2){v[i][1], v[i][3]} : (f32x2){0.f, 0.f};
                        BB = a2 * BB + b2; AA = AA * a2; }
                    *(LAS f32x4*)(SEG + wave * LW + kq * 128 + 2 * lane) = (f32x4){AA.x, BB.x, AA.y, BB.y};
                }
                asm volatile("" ::: "memory");
                { v4u gv8[8];
#pragma unroll
                  for (int i = 0; i < 8; ++i) { const int p = tid + 512 * i, row = p >> 6, c16 = p & 63; gv8[i] = *(const v4u*)(U + (size_t)(grow0 + row) * DIN + 512 + c16 * 8); }
#pragma unroll
                  for (int i = 0; i < 8; ++i) { const int p = tid + 512 * i, row = p >> 6, c16 = p & 63; *(LAS v4u*)(T + row * TSTR + c16 * 16) = gv8[i]; } }
                __syncthreads();
                float carry = 0.f;
#pragma unroll
                for (int w = 0; w < 8; ++w) { const f32x2 sg = SEG[w * LW + tid]; carry = sg.x * carry + sg.y; }
                CARRY[tid] = carry;
            }
            __syncthreads();
            float ss[4][4];
#pragma unroll
            for (int rt = 0; rt < 4; ++rt)
#pragma unroll
                for (int j = 0; j < 4; ++j) ss[rt][j] = 0.f;
#pragma unroll
            for (int ct = 0; ct < 4; ++ct) { asm volatile("" ::: "memory"); const int ch = h * 64 + ct * 16 + c15; const float cr = CARRY[ch];
#pragma unroll
                for (int rt = 0; rt < 4; ++rt)
#pragma unroll
                    for (int jp = 0; jp < 2; ++jp) { const int tl = rt * 16 + 4 * q + 2 * jp;
                        const f32x2 ug = (f32x2){bf_s(*(const LAS unsigned short*)(T + tl * TSTR + ch * 2)), bf_s(*(const LAS unsigned short*)(T + (tl + 1) * TSTR + ch * 2))};
                        const f32x2 ppv = (f32x2){bf_lo(ppk[ct][rt][jp]), bf_hi(ppk[ct][rt][jp])}, crv = (f32x2){cr, cr};
                        const f32x2 hf = (f32x2){hl[ct][rt][2 * jp], hl[ct][rt][2 * jp + 1]} + ppv * crv;
                        const f32x2 y = hf * ug, y2 = y * y;
                        hl[ct][rt][2 * jp] = y.x; hl[ct][rt][2 * jp + 1] = y.y; ss[rt][2 * jp] += y2.x; ss[rt][2 * jp + 1] += y2.y; } }
            {
                float w8[8], w4[4], w2[2];
                const bool b3 = (lane & 8) != 0, b2 = (lane & 4) != 0, b1 = (lane & 2) != 0, b0 = (lane & 1) != 0;
#pragma unroll
                for (int k = 0; k < 8; ++k) { const float lo = ss[k >> 2][k & 3], hi = ss[2 + (k >> 2)][k & 3]; const float keep = b3 ? hi : lo, send = b3 ? lo : hi; w8[k] = keep + __shfl_xor(send, 8); }
#pragma unroll
                for (int k = 0; k < 4; ++k) { const float keep = b2 ? w8[k + 4] : w8[k], send = b2 ? w8[k] : w8[k + 4]; w4[k] = keep + __shfl_xor(send, 4); }
#pragma unroll
                for (int k = 0; k < 2; ++k) { const float keep = b1 ? w4[k + 2] : w4[k], send = b1 ? w4[k] : w4[k + 2]; w2[k] = keep + __shfl_xor(send, 2); }
                const float keep = b0 ? w2[1] : w2[0], send = b0 ? w2[0] : w2[1]; const float tot = keep + __shfl_xor(send, 1);
                SS[((c15 >> 2) * 16 + 4 * q + (c15 & 3)) * 8 + h] = tot;
            }
            __syncthreads();
#pragma unroll
            for (int rt = 0; rt < 4; ++rt)
#pragma unroll
                for (int j = 0; j < 4; ++j) { const int tl = rt * 16 + 4 * q + j; const f32x4 s0 = *(const LAS f32x4*)(SS + tl * 8), s1 = *(const LAS f32x4*)(SS + tl * 8 + 4);
                    ss[rt][j] = __builtin_amdgcn_rsqf(((s0[0] + s0[1]) + (s0[2] + s0[3]) + (s1[0] + s1[1]) + (s1[2] + s1[3])) * (1.0f / 512.0f) + EPS); }
#pragma unroll
            for (int ct = 0; ct < 4; ++ct) { asm volatile("" ::: "memory"); const int ch = h * 64 + ct * 16 + c15;
#pragma unroll
                for (int rt = 0; rt < 4; ++rt)
#pragma unroll
                    for (int jp = 0; jp < 2; ++jp) { const int tl = rt * 16 + 4 * q + 2 * jp;
                        const f32x2 v = (f32x2){hl[ct][rt][2 * jp], hl[ct][rt][2 * jp + 1]} * (f32x2){ss[rt][2 * jp], ss[rt][2 * jp + 1]};
                        const unsigned pw = pk2(v.x, v.y);
                        *(LAS unsigned short*)(T + tl * TSTR + ch * 2) = (unsigned short)(pw & 0xffffu); *(LAS unsigned short*)(T + (tl + 1) * TSTR + ch * 2) = (unsigned short)(pw >> 16); } }
            __syncthreads();
#pragma unroll
            for (int i = 0; i < 8; ++i) { const int p = tid + 512 * i, row = p >> 6, c16 = p & 63; const v4u v = *(const LAS v4u*)(T + row * TSTR + c16 * 16);
                pg8::st16(Y + (size_t)(grow0 + row) * D + c16 * 8, v); }
        }
    }
    GRID_SYNC();

    {
        pg8::Gemm g{Y, Wout_t, M, D, D, 1}; pg8::StaticOrder S; S.init(M, D, G, bx);
        pg8::EpiRes3 E{x, H1B, rowss1};
        pg8::gemm_phase<pg8::EpiRes3, pg8::StaticOrder, true, true>(lds, g, S, E);
    }
    GRID_SYNC();

    {
        pg8::Gemm g{H1B, W13_t, M, N13, D, 1}; pg8::TailSplitOrder S; S.init(M, N13, G, bx);
        pg8::EpiFfn E{HB, rowss1};
        pg8::gemm_phase<pg8::EpiFfn, pg8::TailSplitOrder, true, true>(lds, g, S, E);
    }
    GRID_SYNC();

    {
        pg8::Gemm g{HB, W2_t, M, D, FF, 1}; pg8::StaticOrder S; S.init(M, D, G, bx);
        pg8::EpiFinal E{H1B, out, args.in[20], (float*)(ws + WS_AGG), (unsigned*)(ws + WS_CNT)};
        pg8::gemm_phase<pg8::EpiFinal, pg8::StaticOrder, false, true>(lds, g, S, E);
    }
}

extern "C" void kernel_launch(void* const* d_in, const int* in_sizes, int n_in, void* d_out, int out_size, void* d_ws, size_t ws_size, hipStream_t stream) {
    static int grid = 0;
    if (grid == 0) {
        if (n_in != 21 || out_size != M * D || ws_size < WS_END) { fprintf(stderr, "kernel_launch: unexpected shapes n_in %d out %d ws %zu\n", n_in, out_size, ws_size); grid = -1; return; }
        int dev = 0, cus = 0, per_cu = 0;
        (void)hipGetDevice(&dev); (void)hipDeviceGetAttribute(&cus, hipDeviceAttributeMultiprocessorCount, dev);
        if (hipFuncSetAttribute((const void*)fwd_mega, hipFuncAttributeMaxDynamicSharedMemorySize, LDS_BYTES) != hipSuccess) { fprintf(stderr, "kernel_launch: hipFuncSetAttribute failed\n"); grid = -1; return; }
        (void)hipOccupancyMaxActiveBlocksPerMultiprocessor(&per_cu, (const void*)fwd_mega, NWAVES * 64, LDS_BYTES);
        (void)hipGetLastError();
        if (cus * per_cu < 256) fprintf(stderr, "kernel_launch: co-resident capacity %d x %d < 256 workgroups\n", cus, per_cu);
        grid = 256;
    }
    if (grid < 0) return;
    Args a{};
    for (int i = 0; i < 21; ++i) a.in[i] = (const float*)d_in[i];
    a.out = (float*)d_out; a.ws = (unsigned char*)d_ws;
    if (hipMemsetAsync((char*)d_ws + WS_BAR, 0, BAR_BYTES, stream) != hipSuccess) { fprintf(stderr, "kernel_launch: hipMemsetAsync failed\n"); return; }
    void* kargs[] = {&a};
    hipError_t e = hipLaunchCooperativeKernel((const void*)fwd_mega, dim3(grid), dim3(NWAVES * 64), kargs, LDS_BYTES, stream);
    if (e != hipSuccess) fprintf(stderr, "kernel_launch: cooperative launch failed: %s\n", hipGetErrorString(e));
}
```

```cpp
#include <hip/hip_runtime.h>
#include <hip/hip_cooperative_groups.h>
#include <cstdio>
#include <cstdint>
namespace cg = cooperative_groups;
namespace pg8 {
#define PG8_LAS __attribute__((address_space(3)))
typedef unsigned short bf16_t;
typedef short bf16x8 __attribute__((ext_vector_type(8)));
typedef float f32x4 __attribute__((ext_vector_type(4)));
typedef unsigned u32x4 __attribute__((ext_vector_type(4)));
constexpr int BM = 256, BK = 64, HALF = 128, HTB = HALF * BK * 2  , STAGE_BYTES = 8 * HTB, NXCD = 8, WGM = 4;

__host__ __device__ __forceinline__ int lds_byte(int r, int c) { const int st = (r >> 4) * 2 + (c >> 5), rr = r & 15, cc = c & 31, ob = rr * 64 + cc * 2; return st * 1024 + (ob ^ (((ob >> 9) & 1) << 5)); }
__host__ __device__ __forceinline__ void stage_rc(int b, int& R, int& C) { const int st = b / 1024, sb = b % 1024, swz = sb ^ (((sb >> 9) & 1) << 5); R = (st >> 1) * 16 + swz / 64; C = (st & 1) * 32 + (swz % 64) / 2; }
__host__ __device__ __forceinline__ int perm32(int rho) { const int n = rho >> 4, i = rho & 15; return 8 * (i >> 2) + 4 * n + (i & 3); }

struct Unit { int pm, pn, half; };
struct Gemm { const bf16_t* A; const bf16_t* Bt; int M, N, K, btiled; };

struct StaticOrder {
    int nM, nN, nwg, G, c;
    __host__ __device__ void init(int M, int N, int G_, int c_) { nM = M / BM; nN = N / BM; nwg = nM * nN; G = G_; c = c_; }
    __host__ __device__ bool next(int i, Unit& u) const {
        const long L = (long)i * G + c; if (L >= nwg) return false;
        int wgid = (int)L; { const int q = nwg / NXCD, r = nwg % NXCD, xcd = wgid % NXCD, off = wgid / NXCD; wgid = (xcd < r ? xcd * (q + 1) : r * (q + 1) + (xcd - r) * q) + off; }
        const int nig = WGM * nN, gid = wgid / nig, fm = gid * WGM, gsz = (nM - fm) < WGM ? (nM - fm) : WGM;
        u.pm = fm + ((wgid % nig) % gsz); u.pn = (wgid % nig) / gsz; u.half = 0; return true;
    }
    __device__ __forceinline__ void a_ready(const Unit&) const {}
    __device__ __forceinline__ void done(const Unit&) const {}
};

struct TailSplitOrder : StaticOrder {
    __host__ __device__ bool next(int i, Unit& u) const {
        const int R = nwg / G;
        if (i < R) return StaticOrder::next(i, u);
        if (i > R || (nwg - R * G) * 2 != G) return (i == R) ? StaticOrder::next(i, u) : false;
        StaticOrder t = *this; t.c = 0; t.G = 1;
        if (!t.next(R * G + (c >> 1), u)) return false;
        u.half = 1 + (c & 1); return true;
    }
};

__device__ __forceinline__ unsigned cvt_pk_bf16(float lo, float hi) { unsigned r; asm volatile("v_cvt_pk_bf16_f32 %0, %1, %2" : "=v"(r) : "v"(lo), "v"(hi)); return r; }
typedef float f32x2 __attribute__((ext_vector_type(2)));
#ifndef WT_STORES
#define WT_STORES 0
#endif
__device__ __forceinline__ void st16(void* p, u32x4 v) {
#if WT_STORES
    asm volatile("global_store_dwordx4 %0, %1, off sc1\n\ts_nop 1" :: "v"(p), "v"(v) : "memory");
#else
    *(u32x4*)p = v;
#endif
}
struct EpiU {
    static constexpr bool PERM = true, AFTER_DRAIN = false, HAS_PRE = false;
    bf16_t* O; int ldc;
    static __device__ __forceinline__ f32x2 gelu2(f32x2 v) {
        const f32x2 c0 = (f32x2){-2.302208198f, -2.302208198f}, c1 = (f32x2){0.044715f * -2.302208198f, 0.044715f * -2.302208198f}, one = (f32x2){1.0f, 1.0f};
        const f32x2 z = v * ((v * v) * c1 + c0); f32x2 e; e.x = __builtin_amdgcn_exp2f(z.x); e.y = __builtin_amdgcn_exp2f(z.y);
        const f32x2 d = e + one; f32x2 r; r.x = __builtin_amdgcn_rcpf(d.x); r.y = __builtin_amdgcn_rcpf(d.y); return v * r;
    }
    __device__ __forceinline__ void operator()(const f32x4 (&acc)[2][2][4][2], const Unit& u, int wr, int wc, int fr, int fq) const {
        const int row0 = u.pm * BM + wr * 64 + fr, col0 = u.pn * BM + wc * 32 + 8 * fq;
        const bool gate = (u.pn == 2) || (u.pn == 3);
#pragma unroll
        for (int ai = 0; ai < 2; ++ai)
#pragma unroll
            for (int m = 0; m < 4; ++m) { bf16_t* rowp = O + (size_t)(row0 + ai * HALF + m * 16) * ldc + col0;
#pragma unroll
                for (int bj = 0; bj < 2; ++bj) { f32x4 v0 = acc[ai][bj][m][0], v1 = acc[ai][bj][m][1];
                    if (gate) { const f32x2 a = gelu2((f32x2){v0[0], v0[1]}), b = gelu2((f32x2){v0[2], v0[3]}), c = gelu2((f32x2){v1[0], v1[1]}), d = gelu2((f32x2){v1[2], v1[3]});
                        v0 = (f32x4){a.x, a.y, b.x, b.y}; v1 = (f32x4){c.x, c.y, d.x, d.y}; }
                    u32x4 w; w.x = cvt_pk_bf16(v0[0], v0[1]); w.y = cvt_pk_bf16(v0[2], v0[3]); w.z = cvt_pk_bf16(v1[0], v1[1]); w.w = cvt_pk_bf16(v1[2], v1[3]);
                    st16(rowp + bj * HALF, w); } }
    }
};
template <bool WB> struct EpiRes {
    static constexpr bool PERM = true, AFTER_DRAIN = false, HAS_PRE = false;
    const float* base; float* out; bf16_t* ob; float* rowss;
    __device__ __forceinline__ void operator()(const f32x4 (&acc)[2][2][4][2], const Unit& u, int wr, int wc, int fr, int fq) const {
        const int row0 = u.pm * BM + wr * 64 + fr, col0 = u.pn * BM + wc * 32 + 8 * fq;
#pragma unroll
        for (int ai = 0; ai < 2; ++ai) {
            f32x4 bv[4][2][2];
#pragma unroll
            for (int m = 0; m < 4; ++m)
#pragma unroll
                for (int bj = 0; bj < 2; ++bj) { const float* p = base + (size_t)(row0 + ai * HALF + m * 16) * 1024 + col0 + bj * HALF; bv[m][bj][0] = *(const f32x4*)p; bv[m][bj][1] = *(const f32x4*)(p + 4); }
#pragma unroll
            for (int m = 0; m < 4; ++m) { const int row = row0 + ai * HALF + m * 16; const size_t off = (size_t)row * 1024 + col0; float ss = 0.f;
#pragma unroll
                for (int bj = 0; bj < 2; ++bj) { const size_t p = off + bj * HALF;
                    const f32x4 v0 = acc[ai][bj][m][0] + bv[m][bj][0], v1 = acc[ai][bj][m][1] + bv[m][bj][1];
                    *(f32x4*)(out + p) = v0; *(f32x4*)(out + p + 4) = v1;
                    { const f32x4 sq4 = v0 * v0 + v1 * v1; ss += (sq4[0] + sq4[1]) + (sq4[2] + sq4[3]); }
                    if (WB) { u32x4 w; w.x = cvt_pk_bf16(v0[0], v0[1]); w.y = cvt_pk_bf16(v0[2], v0[3]); w.z = cvt_pk_bf16(v1[0], v1[1]); w.w = cvt_pk_bf16(v1[2], v1[3]); *(u32x4*)(ob + p) = w; } }
                ss += __shfl_xor(ss, 16); ss += __shfl_xor(ss, 32);
                if (fq == 0) unsafeAtomicAdd(rowss + row, ss); }
            asm volatile("" ::: "memory"); }
    }
};
struct EpiRes3 {
    static constexpr bool PERM = true, AFTER_DRAIN = false, HAS_PRE = false;
    const float* base; bf16_t* ob; float* rowss;
    __device__ __forceinline__ void operator()(const f32x4 (&acc)[2][2][4][2], const Unit& u, int wr, int wc, int fr, int fq) const {
        const int row0 = u.pm * BM + wr * 64 + fr, col0 = u.pn * BM + wc * 32 + 8 * fq;
#pragma unroll
        for (int ai = 0; ai < 2; ++ai) {
            f32x4 bv[4][2][2];
#pragma unroll
            for (int m = 0; m < 4; ++m)
#pragma unroll
                for (int bj = 0; bj < 2; ++bj) { const float* p = base + (size_t)(row0 + ai * HALF + m * 16) * 1024 + col0 + bj * HALF; bv[m][bj][0] = *(const f32x4*)p; bv[m][bj][1] = *(const f32x4*)(p + 4); }
#pragma unroll
            for (int m = 0; m < 4; ++m) { const int row = row0 + ai * HALF + m * 16; const size_t off = (size_t)row * 1024 + col0; float ss = 0.f;
#pragma unroll
                for (int bj = 0; bj < 2; ++bj) { const size_t p = off + bj * HALF;
                    const f32x4 v0 = acc[ai][bj][m][0] + bv[m][bj][0], v1 = acc[ai][bj][m][1] + bv[m][bj][1];
                    { const f32x4 sq4 = v0 * v0 + v1 * v1; ss += (sq4[0] + sq4[1]) + (sq4[2] + sq4[3]); }
                    u32x4 w; w.x = cvt_pk_bf16(v0[0], v0[1]); w.y = cvt_pk_bf16(v0[2], v0[3]); w.z = cvt_pk_bf16(v1[0], v1[1]); w.w = cvt_pk_bf16(v1[2], v1[3]); st16(ob + p, w); }
                ss += __shfl_xor(ss, 16); ss += __shfl_xor(ss, 32);
                if (fq == 0) unsafeAtomicAdd(rowss + row, ss); }
            asm volatile("" ::: "memory"); }
    }
};
struct EpiRes5 {
    static constexpr bool PERM = true, AFTER_DRAIN = false, HAS_PRE = false;
    const bf16_t* hb; float* out; float* rowss;
    __device__ __forceinline__ void operator()(const f32x4 (&acc)[2][2][4][2], const Unit& u, int wr, int wc, int fr, int fq) const {
        const int row0 = u.pm * BM + wr * 64 + fr, col0 = u.pn * BM + wc * 32 + 8 * fq;
#pragma unroll
        for (int ai = 0; ai < 2; ++ai) {
            u32x4 bv[4][2];
#pragma unroll
            for (int m = 0; m < 4; ++m)
#pragma unroll
                for (int bj = 0; bj < 2; ++bj) bv[m][bj] = *(const u32x4*)(hb + (size_t)(row0 + ai * HALF + m * 16) * 1024 + col0 + bj * HALF);
#pragma unroll
            for (int m = 0; m < 4; ++m) { const int row = row0 + ai * HALF + m * 16; const size_t off = (size_t)row * 1024 + col0; float ss = 0.f;
#pragma unroll
                for (int bj = 0; bj < 2; ++bj) { const size_t p = off + bj * HALF; const u32x4 h = bv[m][bj];
                    const f32x4 r0 = (f32x4){__uint_as_float(h.x << 16), __uint_as_float(h.x & 0xffff0000u), __uint_as_float(h.y << 16), __uint_as_float(h.y & 0xffff0000u)};
                    const f32x4 r1 = (f32x4){__uint_as_float(h.z << 16), __uint_as_float(h.z & 0xffff0000u), __uint_as_float(h.w << 16), __uint_as_float(h.w & 0xffff0000u)};
                    const f32x4 v0 = acc[ai][bj][m][0] + r0, v1 = acc[ai][bj][m][1] + r1;
                    *(f32x4*)(out + p) = v0; *(f32x4*)(out + p + 4) = v1;
                    { const f32x4 sq4 = v0 * v0 + v1 * v1; ss += (sq4[0] + sq4[1]) + (sq4[2] + sq4[3]); } }
                ss += __shfl_xor(ss, 16); ss += __shfl_xor(ss, 32);
                if (fq == 0) unsafeAtomicAdd(rowss + row, ss); }
            asm volatile("" ::: "memory"); }
    }
};
struct EpiFinal {
    static constexpr bool PERM = true, AFTER_DRAIN = true, HAS_PRE = false;
    const bf16_t* hb; float* out; const float* gfin; float* xbuf; unsigned* cnt;
    __device__ __forceinline__ void preload(const Unit& u, int wr, int wc, int fr, int fq, u32x4 (&pbv)[2][4][2]) const {
        const int row0 = u.pm * BM + wr * 64 + fr, col0 = u.pn * BM + wc * 32 + 8 * fq;
#pragma unroll
        for (int ai = 0; ai < 2; ++ai)
#pragma unroll
            for (int m = 0; m < 4; ++m)
#pragma unroll
                for (int bj = 0; bj < 2; ++bj) pbv[ai][m][bj] = *(const u32x4*)(hb + (size_t)(row0 + ai * HALF + m * 16) * 1024 + col0 + bj * HALF);
    }
    __device__ __forceinline__ void fused(f32x4 (&acc)[2][2][4][2], const Unit& u, int wr, int wc, int fr, int fq, PG8_LAS unsigned char* lds, int wid, int lane, const u32x4 (&pbv)[2][4][2]) const {
        PG8_LAS float* P = (PG8_LAS float*)lds;
        PG8_LAS float* S = (PG8_LAS float*)(lds + 4096);
        const int row0 = u.pm * BM + wr * 64 + fr, col0 = u.pn * BM + wc * 32 + 8 * fq;
#pragma unroll
        for (int ai = 0; ai < 2; ++ai) {
#pragma unroll
            for (int m = 0; m < 4; ++m) { float ss = 0.f;
#pragma unroll
                for (int bj = 0; bj < 2; ++bj) { const u32x4 h = pbv[ai][m][bj];
                    const f32x4 r0 = (f32x4){__uint_as_float(h.x << 16), __uint_as_float(h.x & 0xffff0000u), __uint_as_float(h.y << 16), __uint_as_float(h.y & 0xffff0000u)};
                    const f32x4 r1 = (f32x4){__uint_as_float(h.z << 16), __uint_as_float(h.z & 0xffff0000u), __uint_as_float(h.w << 16), __uint_as_float(h.w & 0xffff0000u)};
                    const f32x4 v0 = acc[ai][bj][m][0] + r0, v1 = acc[ai][bj][m][1] + r1; acc[ai][bj][m][0] = v0; acc[ai][bj][m][1] = v1;
                    { const f32x4 sq4 = v0 * v0 + v1 * v1; ss += (sq4[0] + sq4[1]) + (sq4[2] + sq4[3]); } }
                ss += __shfl_xor(ss, 16); ss += __shfl_xor(ss, 32);
                if (fq == 0) P[(ai * HALF + wr * 64 + m * 16 + fr) * 4 + wc] = ss; }
            asm volatile("" ::: "memory"); }
        asm volatile("s_waitcnt lgkmcnt(0)" ::: "memory"); __builtin_amdgcn_s_barrier(); asm volatile("" ::: "memory");
        const int row = wid * 32 + (lane & 31);
        if (lane < 32) { const f32x4 p = *(const PG8_LAS f32x4*)(P + row * 4);
            __hip_atomic_store(xbuf + ((size_t)(u.pm * BM + row) * 4 + u.pn), (p[0] + p[1]) + (p[2] + p[3]), __ATOMIC_RELAXED, __HIP_MEMORY_SCOPE_AGENT); }
        asm volatile("s_waitcnt vmcnt(0)" ::: "memory");
        if (lane == 0) __hip_atomic_fetch_add(cnt + 64 * u.pm, 1u, __ATOMIC_RELAXED, __HIP_MEMORY_SCOPE_AGENT);
        if (wid == 0) { unsigned sp = 0;
            while ((unsigned)__builtin_amdgcn_readfirstlane(__hip_atomic_load(cnt + 64 * u.pm, __ATOMIC_RELAXED, __HIP_MEMORY_SCOPE_AGENT)) < 32u) { __builtin_amdgcn_s_sleep(2); if (++sp > (1u << 20)) break; }
            __builtin_amdgcn_fence(__ATOMIC_ACQUIRE, "agent"); }
        asm volatile("s_waitcnt vmcnt(0) lgkmcnt(0)" ::: "memory"); __builtin_amdgcn_s_barrier(); asm volatile("" ::: "memory");
        if (lane < 32) { const float* slot = xbuf + (size_t)(u.pm * BM + row) * 4; float t = 0.f;
#pragma unroll
            for (int k = 0; k < 4; ++k) t += __hip_atomic_load(slot + k, __ATOMIC_RELAXED, __HIP_MEMORY_SCOPE_AGENT);
            S[row] = __builtin_amdgcn_rsqf(t * (1.0f / 1024.0f) + 1e-6f); }
        asm volatile("s_waitcnt vmcnt(0) lgkmcnt(0)" ::: "memory"); __builtin_amdgcn_s_barrier(); asm volatile("" ::: "memory");
        f32x4 gv[2][2];
#pragma unroll
        for (int bj = 0; bj < 2; ++bj) { gv[bj][0] = *(const f32x4*)(gfin + col0 + bj * HALF); gv[bj][1] = *(const f32x4*)(gfin + col0 + bj * HALF + 4); }
#pragma unroll
        for (int ai = 0; ai < 2; ++ai)
#pragma unroll
            for (int m = 0; m < 4; ++m) { const int r = ai * HALF + wr * 64 + m * 16 + fr; const float rs = S[r]; float* op = out + (size_t)(u.pm * BM + r) * 1024 + col0;
#pragma unroll
                for (int bj = 0; bj < 2; ++bj) { *(f32x4*)(op + bj * HALF) = acc[ai][bj][m][0] * rs * gv[bj][0]; *(f32x4*)(op + bj * HALF + 4) = acc[ai][bj][m][1] * rs * gv[bj][1]; } }
    }
};
struct EpiFfn {
    static constexpr bool PERM = true, AFTER_DRAIN = false, HAS_PRE = true;
    bf16_t* O; const float* rowss;
    __device__ __forceinline__ void prefetch(const Unit& u, int wr, int wc, int fr, int fq, float (&pre)[8]) const {
        const int row0 = u.pm * BM + (u.half == 2 ? HALF : 0) + wr * 64 + fr;
#pragma unroll
        for (int ai = 0; ai < 2; ++ai)
#pragma unroll
            for (int m = 0; m < 4; ++m) pre[ai * 4 + m] = rowss[row0 + ai * HALF + m * 16];
    }
    __device__ __forceinline__ void operator()(const f32x4 (&acc)[2][2][4][2], const Unit& u, int wr, int wc, int fr, int fq, const float (&pre)[8]) const {
        const int row0 = u.pm * BM + (u.half == 2 ? HALF : 0) + wr * 64 + fr, col0 = u.pn * HALF + wc * 32 + 8 * fq;
#pragma unroll
        for (int ai = 0; ai < 2; ++ai) { if (ai == 1 && u.half != 0) break;
#pragma unroll
            for (int m = 0; m < 4; ++m) { const int row = row0 + ai * HALF + m * 16; const float rstd = __builtin_amdgcn_rsqf(pre[ai * 4 + m] * (1.0f / 1024.0f) + 1e-6f);
                const float r2 = rstd * rstd, nrl = rstd * -1.44269504f;
                const f32x2 r2v = (f32x2){r2, r2}, nrlv = (f32x2){nrl, nrl}, onev = (f32x2){1.0f, 1.0f};
                f32x2 fp[4];
#pragma unroll
                for (int n = 0; n < 2; ++n)
#pragma unroll
                    for (int hh = 0; hh < 2; ++hh) { const f32x4 a4 = acc[ai][0][m][n], b4 = acc[ai][1][m][n];
                        const f32x2 a = hh ? (f32x2){a4[2], a4[3]} : (f32x2){a4[0], a4[1]}, b = hh ? (f32x2){b4[2], b4[3]} : (f32x2){b4[0], b4[1]};
                        const f32x2 t = a * nrlv; f32x2 e; e.x = __builtin_amdgcn_exp2f(t.x); e.y = __builtin_amdgcn_exp2f(t.y);
                        const f32x2 d = e + onev; f32x2 sg; sg.x = __builtin_amdgcn_rcpf(d.x); sg.y = __builtin_amdgcn_rcpf(d.y);
                        fp[n * 2 + hh] = ((a * b) * r2v) * sg; }
                u32x4 w; w.x = cvt_pk_bf16(fp[0].x, fp[0].y); w.y = cvt_pk_bf16(fp[1].x, fp[1].y); w.z = cvt_pk_bf16(fp[2].x, fp[2].y); w.w = cvt_pk_bf16(fp[3].x, fp[3].y);
                st16(O + (size_t)row * 2816 + col0, w); } }
    }
};

template <class Epi, class Sched, bool ALIGN_EPI = false, bool SP2 = false>
__device__ __forceinline__ void gemm_phase(PG8_LAS unsigned char* lds, const Gemm g, const Sched& S, const Epi& E) {
    int tid_l; asm volatile("v_mov_b32 %0, %1" : "=v"(tid_l) : "v"(threadIdx.x));
    const int tid = tid_l, wid = __builtin_amdgcn_readfirstlane(tid >> 6), lane = tid & 63, wr = wid >> 2, wc = wid & 3, fr = lane & 15, fq = lane >> 4;
    const int K = g.K, nt = K / BK;
    unsigned voffA[2], voffB[2];
#pragma unroll
    for (int i = 0; i < 2; ++i) { int R, C; stage_rc(tid * 16 + i * 8192, R, C); const int Rb = Epi::PERM ? ((R & ~31) + perm32(R & 31)) : R;
        voffA[i] = (unsigned)(R * K + C) * 2u; voffB[i] = (unsigned)(Rb * (g.btiled ? BK : K) + C) * 2u; }
    const size_t kstep = (size_t)(BK * 2);
    const size_t hstep = (size_t)HALF * K * 2;
    const size_t tstep = 2 * hstep; const size_t kstepB = g.btiled ? (size_t)(BM * BK * 2) : kstep, hstepB = g.btiled ? (size_t)(HALF * BK * 2) : hstep;
    const unsigned ldsw = (unsigned)wid * 1024u;
    const int aoff = lds_byte(wr * 64 + fr, fq * 8), boff = lds_byte(wc * 32 + fr, fq * 8);
#define PG8_SA(b, h) (((b) * 2 + (h)) * HTB)
#define PG8_SB(b, h) ((4 + (b) * 2 + (h)) * HTB)
#define PG8_STAGE(bufoff, gbase, voff) do { _Pragma("unroll") for (int _i = 0; _i < 2; ++_i) \
        __builtin_amdgcn_global_load_lds((const unsigned*)((const char*)(gbase) + (voff)[_i]), (PG8_LAS unsigned*)(lds + (bufoff) + ldsw + _i * 8192), 16, 0, 0); } while (0)
#define PG8_LDA(dst, b, h) do { _Pragma("unroll") for (int m = 0; m < 4; ++m) _Pragma("unroll") for (int k = 0; k < 2; ++k) dst[m][k] = *(const PG8_LAS bf16x8*)(lds + PG8_SA(b, h) + aoff + m * 2048 + k * 1024); } while (0)
#define PG8_LDB(dst, b, h) do { _Pragma("unroll") for (int n = 0; n < 2; ++n) _Pragma("unroll") for (int k = 0; k < 2; ++k) dst[n][k] = *(const PG8_LAS bf16x8*)(lds + PG8_SB(b, h) + boff + n * 2048 + k * 1024); } while (0)
#define PG8_MMA(ai, bj, At, Bt) do { __builtin_amdgcn_s_setprio(1); _Pragma("unroll") for (int m = 0; m < 4; ++m) _Pragma("unroll") for (int n = 0; n < 2; ++n) _Pragma("unroll") for (int k = 0; k < 2; ++k) \
        acc[ai][bj][m][n] = __builtin_amdgcn_mfma_f32_16x16x32_bf16(Bt[n][k], At[m][k], acc[ai][bj][m][n], 0, 0, 0); __builtin_amdgcn_s_setprio(0); } while (0)
#define PG8_WAIT_V(n) asm volatile("s_waitcnt vmcnt(" #n ")" ::: "memory")
#define PG8_WAIT_L(n) asm volatile("s_waitcnt lgkmcnt(" #n ")" ::: "memory")
#define PG8_BAR __builtin_amdgcn_s_barrier()
#define PG8_SCHED __builtin_amdgcn_sched_barrier(0)
    Unit cur, nxt; int ui = 0;
    if (!S.next(0, cur)) return;
    f32x4 acc[2][2][4][2];
#pragma unroll
    for (int a = 0; a < 2; ++a)
#pragma unroll
        for (int b = 0; b < 2; ++b)
#pragma unroll
            for (int m = 0; m < 4; ++m)
#pragma unroll
                for (int n = 0; n < 2; ++n) acc[a][b][m][n] = (f32x4){0.f, 0.f, 0.f, 0.f};
    bf16x8 At[4][2], B0[2][2], B1[2][2];
    const char* cA = (const char*)g.A + (size_t)cur.pm * tstep + (cur.half == 2 ? hstep : (size_t)0); const char* cB = (const char*)g.Bt + (size_t)cur.pn * tstep;
    float pre[8];
    if constexpr (Epi::HAS_PRE) E.prefetch(cur, wr, wc, fr, fq, pre);
    S.a_ready(cur);
    if constexpr (SP2) {
        PG8_STAGE(PG8_SB(0, 0), cB, voffB); PG8_STAGE(PG8_SB(0, 1), cB + hstepB, voffB); PG8_STAGE(PG8_SA(0, 0), cA, voffA); PG8_STAGE(PG8_SA(0, 1), cA + hstep, voffA);
        if (wr == 1) PG8_BAR;
        PG8_WAIT_V(2); PG8_BAR;
        PG8_STAGE(PG8_SB(1, 0), cB + kstepB, voffB); PG8_STAGE(PG8_SA(1, 0), cA + kstep, voffA); PG8_STAGE(PG8_SB(1, 1), cB + hstepB + kstepB, voffB);
        PG8_WAIT_V(6); PG8_BAR;
    } else {
        PG8_STAGE(PG8_SB(0, 0), cB, voffB); PG8_STAGE(PG8_SA(0, 0), cA, voffA); PG8_STAGE(PG8_SB(0, 1), cB + hstepB, voffB); PG8_STAGE(PG8_SA(0, 1), cA + hstep, voffA);
        if (wr == 1) PG8_BAR;
        PG8_WAIT_V(4); PG8_BAR;
        PG8_STAGE(PG8_SB(1, 0), cB + kstepB, voffB); PG8_STAGE(PG8_SA(1, 0), cA + kstep, voffA); PG8_STAGE(PG8_SB(1, 1), cB + hstepB + kstepB, voffB);
        PG8_WAIT_V(6); PG8_BAR;
    }
    for (;;) {
        const bool has_next = S.next(ui + 1, nxt);
        const char* nA = has_next ? (const char*)g.A + (size_t)nxt.pm * tstep + (nxt.half == 2 ? hstep : (size_t)0) : cA; const char* nB = has_next ? (const char*)g.Bt + (size_t)nxt.pn * tstep : cB;
        const bool fullu = (cur.half == 0);
        for (int t = 0; t < nt; t += 2) {
            const bool last = (t == nt - 2);
            const char* a1 = cA + (size_t)(t + 1) * kstep;
            const char* a2 = last ? nA : cA + (size_t)(t + 2) * kstep; const char* b2 = last ? nB : cB + (size_t)(t + 2) * kstepB;
            const char* a3 = a2 + kstep; const char* b3 = b2 + kstepB;
            if (last && has_next) S.a_ready(nxt);
            if constexpr (SP2) {
            PG8_LDB(B0, 0, 0); PG8_LDB(B1, 0, 1); PG8_SCHED; PG8_LDA(At, 0, 0); PG8_STAGE(PG8_SA(1, 1), a1 + hstep, voffA);
            PG8_WAIT_V(8); PG8_WAIT_L(0); PG8_BAR; PG8_MMA(0, 0, At, B0); PG8_MMA(0, 1, At, B1); PG8_BAR; PG8_SCHED;
            PG8_LDA(At, 0, 1); PG8_STAGE(PG8_SB(0, 0), b2, voffB); PG8_STAGE(PG8_SB(0, 1), b2 + hstepB, voffB); PG8_STAGE(PG8_SA(0, 0), a2, voffA);
            PG8_WAIT_V(8); PG8_WAIT_L(0); PG8_BAR; if (fullu) { PG8_MMA(1, 0, At, B0); PG8_MMA(1, 1, At, B1); } PG8_BAR; PG8_SCHED;
            PG8_LDB(B0, 1, 0); PG8_LDB(B1, 1, 1); PG8_SCHED; PG8_LDA(At, 1, 0); PG8_STAGE(PG8_SA(0, 1), a2 + hstep, voffA);
            PG8_WAIT_V(8); PG8_WAIT_L(0); PG8_BAR; PG8_MMA(0, 0, At, B0); PG8_MMA(0, 1, At, B1); PG8_BAR; PG8_SCHED;
            PG8_LDA(At, 1, 1); PG8_STAGE(PG8_SB(1, 0), b3, voffB); PG8_STAGE(PG8_SB(1, 1), b3 + hstepB, voffB); PG8_STAGE(PG8_SA(1, 0), a3, voffA);
            PG8_WAIT_V(8); PG8_WAIT_L(0); PG8_BAR; if (fullu) { PG8_MMA(1, 0, At, B0); PG8_MMA(1, 1, At, B1); } PG8_BAR; PG8_SCHED;
            } else {
            PG8_LDB(B0, 0, 0); PG8_SCHED; PG8_LDA(At, 0, 0); PG8_STAGE(PG8_SA(1, 1), a1 + hstep, voffA);
            PG8_WAIT_L(8); PG8_BAR; PG8_WAIT_L(0); PG8_MMA(0, 0, At, B0); PG8_BAR; PG8_SCHED;
            PG8_LDB(B1, 0, 1); PG8_STAGE(PG8_SB(0, 0), b2, voffB);
            PG8_BAR; PG8_WAIT_L(0); PG8_MMA(0, 1, At, B1); PG8_BAR;
            PG8_LDA(At, 0, 1); PG8_STAGE(PG8_SA(0, 0), a2, voffA);
            PG8_BAR; PG8_WAIT_L(0); PG8_MMA(1, 0, At, B0); PG8_BAR; PG8_SCHED;
            PG8_STAGE(PG8_SB(0, 1), b2 + hstepB, voffB);
            PG8_WAIT_V(6); PG8_BAR; PG8_MMA(1, 1, At, B1); PG8_BAR;
            PG8_LDB(B0, 1, 0); PG8_SCHED; PG8_LDA(At, 1, 0); PG8_STAGE(PG8_SA(0, 1), a2 + hstep, voffA);
            PG8_WAIT_L(8); PG8_BAR; PG8_WAIT_L(0); PG8_MMA(0, 0, At, B0); PG8_BAR; PG8_SCHED;
            PG8_LDB(B1, 1, 1); PG8_STAGE(PG8_SB(1, 0), b3, voffB);
            PG8_BAR; PG8_WAIT_L(0); PG8_MMA(0, 1, At, B1); PG8_BAR;
            PG8_LDA(At, 1, 1); PG8_STAGE(PG8_SA(1, 0), a3, voffA);
            PG8_BAR; PG8_WAIT_L(0); PG8_MMA(1, 0, At, B0); PG8_BAR; PG8_SCHED;
            PG8_STAGE(PG8_SB(1, 1), b3 + hstepB, voffB);
            PG8_WAIT_V(6); PG8_BAR; PG8_MMA(1, 1, At, B1); PG8_BAR;
            }
        }
        if constexpr (ALIGN_EPI) { if (wr == 0) PG8_BAR; }
        if constexpr (!Epi::AFTER_DRAIN) { if constexpr (Epi::HAS_PRE) E(acc, cur, wr, wc, fr, fq, pre); else E(acc, cur, wr, wc, fr, fq); S.done(cur); }
        if constexpr (Epi::HAS_PRE) { if (has_next) E.prefetch(nxt, wr, wc, fr, fq, pre); }
        if (!has_next) break;
#pragma unroll
        for (int a = 0; a < 2; ++a)
#pragma unroll
            for (int b = 0; b < 2; ++b)
#pragma unroll
                for (int m = 0; m < 4; ++m)
#pragma unroll
                    for (int n = 0; n < 2; ++n) acc[a][b][m][n] = (f32x4){0.f, 0.f, 0.f, 0.f};
        cur = nxt; cA = nA; cB = nB; ++ui;
        if constexpr (ALIGN_EPI) { if (wr == 1) PG8_BAR; }
    }
    u32x4 pbv[2][4][2];
    if constexpr (Epi::AFTER_DRAIN) E.preload(cur, wr, wc, fr, fq, pbv);
    PG8_WAIT_V(0);
    if constexpr (!ALIGN_EPI) { if (wr == 0) PG8_BAR; }
    PG8_BAR;
    if constexpr (Epi::AFTER_DRAIN) { E.fused(acc, cur, wr, wc, fr, fq, lds, wid, lane, pbv); S.done(cur); }
#undef PG8_SA
#undef PG8_SB
#undef PG8_STAGE
#undef PG8_LDA
#undef PG8_LDB
#undef PG8_MMA
#undef PG8_WAIT_V
#undef PG8_WAIT_L
#undef PG8_BAR
#undef PG8_SCHED
}
}
#define LAS __attribute__((address_space(3)))
typedef unsigned short bf16;
typedef unsigned v4u __attribute__((ext_vector_type(4)));
typedef unsigned v2u __attribute__((ext_vector_type(2)));
typedef float f32x4 __attribute__((ext_vector_type(4)));
typedef float f32x2 __attribute__((ext_vector_type(2)));
typedef short bf16x8 __attribute__((ext_vector_type(8)));

constexpr int NWAVES = 8;
constexpr int M = 16384, D = 1024, DIN = 1536, LW = 512, FF = 2816, N13 = 2 * FF, SEQ = 8192, TC = 64, NCHUNK = M / TC;
constexpr float EPS = 1e-6f;
constexpr size_t MiB = 1u << 20;
constexpr size_t WS_SS1 = 0, WS_SS2 = 65536, WS_BAR = 131072, WS_CNT = WS_BAR + 16384, WS_SB = WS_BAR + 32768, BAR_BYTES = 32768 + 8192, WS_AGG = 1 * MiB;
constexpr size_t WS_WIN = 2 * MiB, WS_WOUT = 5 * MiB, WS_W13 = 7 * MiB, WS_W2 = 18 * MiB, WS_WGA = 24 * MiB, WS_WGX = WS_WGA + 65536, WS_WP = WS_WGA + 131072;
constexpr size_t WS_XN = 32 * MiB;
constexpr size_t WS_H1B = 64 * MiB;
constexpr size_t WS_U = 96 * MiB;
constexpr size_t WS_H = 144 * MiB;
constexpr size_t WS_END = 232 * MiB;
constexpr int RING_BYTES = 131072, TSTR = 1040, PT_OFF = 64 * TSTR  , SS_OFF = PT_OFF + 79 * TSTR  , CARRY_OFF = SS_OFF + 2048, LDS_BYTES = 155648, MISC_OFF = LDS_BYTES - 128;

#define LDS_WAIT() asm volatile("s_waitcnt lgkmcnt(0)" ::: "memory")
__device__ __forceinline__ float bf_lo(unsigned w) { return __uint_as_float(w << 16); }
__device__ __forceinline__ float bf_hi(unsigned w) { return __uint_as_float(w & 0xffff0000u); }
__device__ __forceinline__ float bf_s(unsigned short h) { return __uint_as_float(((unsigned)h) << 16); }
__device__ __forceinline__ unsigned pk2(float lo, float hi) { return pg8::cvt_pk_bf16(lo, hi); }
__device__ __forceinline__ void unpack8(const v4u v, float (&c)[8]) { c[0] = bf_lo(v.x); c[1] = bf_hi(v.x); c[2] = bf_lo(v.y); c[3] = bf_hi(v.y); c[4] = bf_lo(v.z); c[5] = bf_hi(v.z); c[6] = bf_lo(v.w); c[7] = bf_hi(v.w); }
__device__ __forceinline__ float sigmoid_(float x) { return __builtin_amdgcn_rcpf(1.0f + __expf(-x)); }
__device__ __forceinline__ float nexpm1(float x) {
    const float p = x * (1.0f + x * (0.5f + x * (0.16666667f + x * (0.041666668f + x * (0.0083333338f + x * (0.0013888889f + x * 0.0001984127f))))));
    const float e = 1.0f - __expf(x);
    return x > -0.25f ? -p : e;
}
__device__ __forceinline__ float one_minus_a2(float la, float a) {
    (void)la; return 1.0f - a * a;
}
__device__ __forceinline__ float wave_sum(float v) {
#pragma unroll
    for (int o = 1; o < 64; o <<= 1) v += __shfl_xor(v, o);
    return v;
}

struct TItem { const float* W; bf16* WT; const float* kscale; int N, ldt, k0, n0, drow0; };
__device__ __forceinline__ void t_load(const TItem& it, int lane, f32x4 (&t)[8]) {
#pragma unroll
    for (int i = 0; i < 8; ++i) t[i] = *(const f32x4*)(it.W + (size_t)(it.k0 + 8 * i + (lane >> 3)) * it.N + it.n0 + 4 * (lane & 7));
}
__device__ __forceinline__ void t_proc(const TItem& it, const f32x4 (&t)[8], LAS float* scr, int lane) {
#pragma unroll
    for (int i = 0; i < 8; ++i) { LAS float* d = scr + (8 * i + (lane >> 3)) * 33 + 4 * (lane & 7); d[0] = t[i][0]; d[1] = t[i][1]; d[2] = t[i][2]; d[3] = t[i][3]; }
    LDS_WAIT(); asm volatile("" ::: "memory");
    const int c = lane & 7;
    float ks[8];
#pragma unroll
    for (int i = 0; i < 8; ++i) ks[i] = it.kscale ? it.kscale[it.k0 + 8 * c + i] : 1.0f;
#pragma unroll
    for (int j = 0; j < 4; ++j) { const int n = (lane >> 3) + 8 * j; const LAS float* sp = scr + (8 * c) * 33 + n;
        v4u o; o.x = pk2(sp[0 * 33] * ks[0], sp[1 * 33] * ks[1]); o.y = pk2(sp[2 * 33] * ks[2], sp[3 * 33] * ks[3]); o.z = pk2(sp[4 * 33] * ks[4], sp[5 * 33] * ks[5]); o.w = pk2(sp[6 * 33] * ks[6], sp[7 * 33] * ks[7]);
        *(v4u*)(it.WT + (size_t)(it.drow0 + n) * it.ldt + it.k0 + 8 * c) = o; }
    LDS_WAIT(); asm volatile("" ::: "memory");
}
#define T_RUN(first, stride, n, DEC, scr, lane) do { int it_ = (first); if (it_ < (n)) { TItem cur_; f32x4 ta_[8]; DEC(it_, cur_); t_load(cur_, (lane), ta_); \
        for (;;) { const int nx_ = it_ + (stride); const bool has_ = nx_ < (n); TItem nxt_ = cur_; f32x4 tb_[8]; if (has_) { DEC(nx_, nxt_); t_load(nxt_, (lane), tb_); } \
            t_proc(cur_, ta_, (scr), (lane)); if (!has_) break; cur_ = nxt_; _Pragma("unroll") for (int q_ = 0; q_ < 8; ++q_) ta_[q_] = tb_[q_]; it_ = nx_; } } } while (0)

struct BTile { const float* W; bf16* WT; const float* kscale; int N, ldt, k0, n0, mode; };
__device__ __forceinline__ void bt_load(const BTile& t, int wave, int lane, f32x4 (&r)[8], f32x4 (&ksv)[2]) {
    if (t.kscale) { ksv[0] = *(const f32x4*)(t.kscale + t.k0 + 8 * (lane & 7)); ksv[1] = *(const f32x4*)(t.kscale + t.k0 + 8 * (lane & 7) + 4); }
    else { ksv[0] = (f32x4){1.f, 1.f, 1.f, 1.f}; ksv[1] = ksv[0]; }
#pragma unroll
    for (int i = 0; i < 8; ++i) r[i] = *(const f32x4*)(t.W + (size_t)(t.k0 + 8 * wave + i) * t.N + t.n0 + 4 * lane);
}
__device__ __forceinline__ void bt_proc(const BTile& t, const f32x4 (&r)[8], const f32x4 (&ksv)[2], LAS float* tile  , int wave, int lane) {
    const int c = lane & 7, nr = lane >> 3;
    const float ks[8] = {ksv[0][0], ksv[0][1], ksv[0][2], ksv[0][3], ksv[1][0], ksv[1][1], ksv[1][2], ksv[1][3]};
#pragma unroll
    for (int i = 0; i < 8; ++i) { LAS float* d = tile + (8 * wave + i) * 257 + 4 * lane; d[0] = r[i][0]; d[1] = r[i][1]; d[2] = r[i][2]; d[3] = r[i][3]; }
    __syncthreads();
#pragma unroll
    for (int j = 0; j < 4; ++j) { const int n = 32 * wave + 8 * j + nr; const LAS float* sp = tile + (8 * c) * 257 + n;
        v4u o; o.x = pk2(sp[0 * 257] * ks[0], sp[1 * 257] * ks[1]); o.y = pk2(sp[2 * 257] * ks[2], sp[3 * 257] * ks[3]); o.z = pk2(sp[4 * 257] * ks[4], sp[5 * 257] * ks[5]); o.w = pk2(sp[6 * 257] * ks[6], sp[7 * 257] * ks[7]);
        const int gn = t.n0 + n, drow = t.mode == 0 ? gn : 256 * (gn >> 7) + (gn & 127) + (t.mode == 2 ? 128 : 0);
        *(v4u*)(t.WT + (size_t)(drow >> 8) * (256 * (size_t)t.ldt) + (size_t)(t.k0 >> 6) * (256 * 64) + (size_t)(drow & 255) * 64 + 8 * c) = o; }
    __syncthreads();
}

#define XB_TMO      128
#define XB_XCNT(j)  (256  + 64 * (j))
#define XB_XSUB(j)  (1280 + 64 * (j))
#define XB_XGEN(j)  (2304 + 64 * (j))
#define XB_TOP      3328
#define XB_TOPGEN   3392
#define XCD_BAR_WORDS 3456
#define XB_SPIN_CAP (1u << 18)

__device__ __forceinline__ unsigned xb_ld(unsigned* p)              { return __hip_atomic_load(p, __ATOMIC_RELAXED, __HIP_MEMORY_SCOPE_AGENT); }
__device__ __forceinline__ unsigned xb_add(unsigned* p, unsigned v) { return __hip_atomic_fetch_add(p, v, __ATOMIC_RELAXED, __HIP_MEMORY_SCOPE_AGENT); }
__device__ __forceinline__ unsigned xb_xcc_id() { return (unsigned)__builtin_amdgcn_s_getreg((3 << 11) | 20) & 0xFu; }
#define XB_SPIN(cond, bar) do { unsigned _sp = 0; while (cond) { __builtin_amdgcn_s_sleep(1); \
    if ((++_sp & 255u) == 0u) { if (xb_ld(&(bar)[XB_TMO])) break; if (_sp > XB_SPIN_CAP) { atomicAdd(&(bar)[XB_TMO], 1u); break; } } } } while (0)

struct XcdBarrier {
    unsigned* bar; unsigned x;
    volatile LAS unsigned* st;
};

__device__ __forceinline__ XcdBarrier xcd_barrier_post(unsigned* bar, volatile LAS unsigned* st) {
    XcdBarrier b; b.bar = bar; b.x = xb_xcc_id(); b.st = st;
    if (threadIdx.x == 0) (void)xb_add(&bar[XB_XCNT(b.x)], 1u);
    return b;
}
__device__ __forceinline__ void xcd_barrier_complete(unsigned* bar, unsigned x, unsigned& nloc, unsigned& nx) {
    const unsigned G = gridDim.x * gridDim.y * gridDim.z;
    unsigned sum, cnt, mine, sp = 0u;
    for (;;) {
        sum = 0u; cnt = 0u; mine = 0u;
#pragma unroll
        for (unsigned j = 0; j < 16; ++j) { const unsigned c = xb_ld(&bar[XB_XCNT(j)]); sum += c; cnt += (c > 0u) ? 1u : 0u; mine = (j == x) ? c : mine; }
        if (sum == G) break;
        __builtin_amdgcn_s_sleep(1);
        if ((++sp & 255u) == 0u) { if (xb_ld(&bar[XB_TMO])) break; if (sp > XB_SPIN_CAP) { atomicAdd(&bar[XB_TMO], 1u); break; } }
    }
    nloc = mine > 0u ? mine : 1u; nx = cnt > 0u ? cnt : 1u;
}

__device__ __forceinline__ void xcd_barrier(const XcdBarrier& b) {
    asm volatile("s_waitcnt vmcnt(0)" ::: "memory");
    __syncthreads();
    if (threadIdx.x == 0) {
        unsigned* bar = b.bar;
        __builtin_amdgcn_s_waitcnt(0);
        unsigned nloc = b.st[0], nx = b.st[1];
        if (nloc == 0u) { xcd_barrier_complete(bar, b.x, nloc, nx); b.st[0] = nloc; b.st[1] = nx; }
        const unsigned old = xb_add(&bar[XB_XSUB(b.x)], 1u);
        const unsigned gen = old / nloc;
        if (old + 1u == (gen + 1u) * nloc) {
            __builtin_amdgcn_fence(__ATOMIC_RELEASE, "agent");
            asm volatile("s_waitcnt vmcnt(0)" ::: "memory");
            const unsigned og = xb_add(&bar[XB_TOP], 1u);
            const unsigned tg = og / nx;
            if (og + 1u == (tg + 1u) * nx) xb_add(&bar[XB_TOPGEN], 1u);
            else XB_SPIN(xb_ld(&bar[XB_TOPGEN]) == tg, bar);
            __builtin_amdgcn_fence(__ATOMIC_ACQUIRE, "agent");
            xb_add(&bar[XB_XGEN(b.x)], 1u);
            asm volatile("s_waitcnt vmcnt(0)" ::: "memory");
        } else {
            XB_SPIN(xb_ld(&bar[XB_XGEN(b.x)]) == gen, bar);
            __builtin_amdgcn_fence(__ATOMIC_ACQUIRE, "agent");
            asm volatile("s_waitcnt vmcnt(0)" ::: "memory");
        }
    }
    __syncthreads();
}

__device__ __forceinline__ void sb_arrive(unsigned* ctr) {
    asm volatile("s_waitcnt vmcnt(0)" ::: "memory");
    __syncthreads();
    if (threadIdx.x == 0) { __builtin_amdgcn_fence(__ATOMIC_RELEASE, "agent"); asm volatile("s_waitcnt vmcnt(0)" ::: "memory"); __hip_atomic_fetch_add(ctr, 1u, __ATOMIC_RELAXED, __HIP_MEMORY_SCOPE_AGENT); }
}
__device__ __forceinline__ void sb_wait(unsigned* ctr, unsigned n) {
    if (threadIdx.x == 0) { unsigned sp = 0;
        while (__hip_atomic_load(ctr, __ATOMIC_RELAXED, __HIP_MEMORY_SCOPE_AGENT) < n) { __builtin_amdgcn_s_sleep(1); if (++sp > (1u << 22)) break; }
        __builtin_amdgcn_fence(__ATOMIC_ACQUIRE, "agent"); asm volatile("s_waitcnt vmcnt(0)" ::: "memory"); }
    __syncthreads();
}
__device__ __forceinline__ void sbx_arrive(unsigned* sub, const XcdBarrier& b) {
    asm volatile("s_waitcnt vmcnt(0)" ::: "memory");
    __syncthreads();
    if (threadIdx.x == 0) { const unsigned nloc = b.st[0];
        const unsigned old = __hip_atomic_fetch_add(sub + 64 * b.x, 1u, __ATOMIC_RELAXED, __HIP_MEMORY_SCOPE_AGENT);
        if (old + 1u == nloc) { __builtin_amdgcn_fence(__ATOMIC_RELEASE, "agent"); asm volatile("s_waitcnt vmcnt(0)" ::: "memory"); __hip_atomic_fetch_add(sub + 64 * 16, 1u, __ATOMIC_RELAXED, __HIP_MEMORY_SCOPE_AGENT); } }
}
__device__ __forceinline__ void sbx_wait(unsigned* sub, const XcdBarrier& b) {
    if (threadIdx.x == 0) { const unsigned nx = b.st[1]; unsigned sp = 0;
        while (__hip_atomic_load(sub + 64 * 16, __ATOMIC_RELAXED, __HIP_MEMORY_SCOPE_AGENT) < nx) { __builtin_amdgcn_s_sleep(1); if (++sp > (1u << 22)) break; }
        __builtin_amdgcn_fence(__ATOMIC_ACQUIRE, "agent"); asm volatile("s_waitcnt vmcnt(0)" ::: "memory"); }
    __syncthreads();
}
struct Args { const float* in[21]; float* out; unsigned char* ws; };

__global__ void __launch_bounds__(NWAVES * 64, 2) fwd_mega(Args args) {
    extern __shared__ __attribute__((aligned(16))) unsigned char lds_raw[];
    LAS unsigned char* lds = (LAS unsigned char*)lds_raw;
    cg::grid_group grid = cg::this_grid();
    if (args.ws == nullptr) grid.sync();
    { volatile LAS unsigned* misc = (volatile LAS unsigned*)((LAS unsigned char*)lds_raw + MISC_OFF); if (threadIdx.x < 32) misc[threadIdx.x] = 0u; }
    __syncthreads();
    const XcdBarrier gbar = xcd_barrier_post((unsigned*)(args.ws + WS_BAR), (volatile LAS unsigned*)((LAS unsigned char*)lds_raw + MISC_OFF) + 8);
#define GRID_SYNC() xcd_barrier(gbar)
    const int tid = threadIdx.x, lane = tid & 63, wave = __builtin_amdgcn_readfirstlane(tid >> 6);
    const int G = gridDim.x, bx = blockIdx.x;
    unsigned char* ws = args.ws;
    const float* x = args.in[0]; float* out = args.out;
    float* rowss1 = (float*)(ws + WS_SS1); float* rowss2 = (float*)(ws + WS_SS2); f32x2* agg = (f32x2*)(ws + WS_AGG);
    bf16* Win_t = (bf16*)(ws + WS_WIN); bf16* Wout_t = (bf16*)(ws + WS_WOUT); bf16* W13_t = (bf16*)(ws + WS_W13); bf16* W2_t = (bf16*)(ws + WS_W2);
    bf16* WGA_t = (bf16*)(ws + WS_WGA); bf16* WGX_t = (bf16*)(ws + WS_WGX); bf16* WP_t = (bf16*)(ws + WS_WP);
    bf16* XN = (bf16*)(ws + WS_XN); bf16* Y = XN; bf16* H1B = (bf16*)(ws + WS_H1B); bf16* U = (bf16*)(ws + WS_U); bf16* HB = (bf16*)(ws + WS_H);

    {
        const int gw = bx * NWAVES + wave, NGW = G * NWAVES;
        for (int i = bx * (NWAVES * 64) + tid; i < 2 * M; i += G * NWAVES * 64) rowss1[i] = 0.f;
        LAS float* scr = (LAS float*)(lds + wave * 16384);
        constexpr int I_IN = (D / 64) * (DIN / 32), I_G = 16, I_P = 32;
        constexpr int NITEMS = I_IN + 2 * I_G + I_P;
#define DEC_P0(r_, T_) do { int r = (r_); \
            if (r < I_IN) { const int nb = r % (DIN / 32), kb = r / (DIN / 32); T_ = TItem{args.in[2], Win_t, nullptr, DIN, D, 64 * kb, 32 * nb, 32 * nb}; } \
            else if ((r -= I_IN) < I_G) { const int hh = r >> 1, nb = r & 1; T_ = TItem{args.in[5] + hh * 4096, WGA_t + hh * 4096, nullptr, 64, 64, 0, 32 * nb, 32 * nb}; } \
            else if ((r -= I_G) < I_G) { const int hh = r >> 1, nb = r & 1; T_ = TItem{args.in[7] + hh * 4096, WGX_t + hh * 4096, nullptr, 64, 64, 0, 32 * nb, 32 * nb}; } \
            else { r -= I_G; const int gg = r >> 3, q8 = r & 7, kb = q8 >> 2, nb = q8 & 3; T_ = TItem{args.in[10] + gg * 16384, WP_t + gg * 16384, nullptr, 128, 128, 64 * kb, 32 * nb, 32 * nb}; } } while (0)
        T_RUN(gw, NGW, NITEMS, DEC_P0, scr, lane);
#undef DEC_P0
        const f32x4* gp = (const f32x4*)args.in[1] + lane;
        f32x4 gv[4];
#pragma unroll
        for (int j = 0; j < 4; ++j) gv[j] = gp[64 * j];
        constexpr int NGRP = M / 4;
        const int vb = (G == 256) ? ((bx & 7) * 32 + (bx >> 3)) : bx;
        for (int pass = 0; pass < 2; ++pass) {
            const int grp = 16 * vb + 8 * pass + wave; if (grp >= NGRP) break;
            const int m0 = grp * 4;
            f32x4 v[4][4]; float sq[4];
#pragma unroll
            for (int r = 0; r < 4; ++r) { const f32x4* xr = (const f32x4*)(x + (size_t)(m0 + r) * D) + lane;
#pragma unroll
                for (int j = 0; j < 4; ++j) v[r][j] = xr[64 * j]; }
#pragma unroll
            for (int r = 0; r < 4; ++r) { float s2 = 0.f;
#pragma unroll
                for (int j = 0; j < 4; ++j) { const f32x4 vv = v[r][j] * v[r][j]; s2 += (vv.x + vv.y) + (vv.z + vv.w); }
                sq[r] = s2; }
#pragma unroll
            for (int o = 1; o < 64; o <<= 1) {
#pragma unroll
                for (int r = 0; r < 4; ++r) sq[r] += __shfl_xor(sq[r], o); }
#pragma unroll
            for (int r = 0; r < 4; ++r) { const float rstd = __builtin_amdgcn_rsqf(sq[r] * (1.0f / D) + EPS);
                unsigned long long* o8 = (unsigned long long*)(XN + (size_t)(m0 + r) * D) + lane;
#pragma unroll
                for (int j = 0; j < 4; ++j) { const f32x4 y = v[r][j] * rstd * gv[j]; o8[64 * j] = (unsigned long long)pk2(y.x, y.y) | ((unsigned long long)pk2(y.z, y.w) << 32); } }
        }
    }
    GRID_SYNC();

    {
        pg8::Gemm g{XN, Win_t, M, DIN, D, 0}; pg8::StaticOrder S; S.init(M, DIN, G, bx);
        pg8::EpiU E{U, DIN};
        pg8::gemm_phase<pg8::EpiU, pg8::StaticOrder, true, true>(lds, g, S, E);
        if (bx >= 128) {
            int lane_d; asm volatile("v_and_b32 %0, 63, %1" : "=v"(lane_d) : "v"(threadIdx.x));
            LAS float* tile = (LAS float*)lds;
            constexpr int T_OUT = (D / 64) * (D / 256), T_1 = (D / 64) * (FF / 256), T_2 = (FF / 64) * (D / 256), NT = T_OUT + 2 * T_1 + T_2;
#define DEC_BT(r_, T_) do { int r = (r_); \
                if (r < T_OUT) { const int nb = r % (D / 256), kb = r / (D / 256); T_ = BTile{args.in[15], Wout_t, (64 * kb < LW) ? args.in[13] : args.in[14] - LW, D, D, 64 * kb, 256 * nb, 0}; } \
                else if ((r -= T_OUT) < T_1) { const int nb = r % (FF / 256), kb = r / (FF / 256); T_ = BTile{args.in[17], W13_t, args.in[16], FF, D, 64 * kb, 256 * nb, 1}; } \
                else if ((r -= T_1) < T_1) { const int nb = r % (FF / 256), kb = r / (FF / 256); T_ = BTile{args.in[18], W13_t, args.in[16], FF, D, 64 * kb, 256 * nb, 2}; } \
                else { r -= T_1; const int nb = r % (D / 256), kb = r / (D / 256); T_ = BTile{args.in[19], W2_t, nullptr, D, FF, 64 * kb, 256 * nb, 0}; } } while (0)
            { int it = bx - 128; BTile cur; f32x4 ta[8], ka[2]; DEC_BT(it, cur); bt_load(cur, wave, lane_d, ta, ka);
              for (;;) { const int nx = it + 128; const bool has = nx < NT; BTile nxt = cur; f32x4 tb[8], kb2[2]; if (has) { DEC_BT(nx, nxt); bt_load(nxt, wave, lane_d, tb, kb2); }
                  bt_proc(cur, ta, ka, tile, wave, lane_d); if (!has) break; cur = nxt;
#pragma unroll
                  for (int q_ = 0; q_ < 8; ++q_) ta[q_] = tb[q_];
                  ka[0] = kb2[0]; ka[1] = kb2[1];
                  it = nx; } }
#undef DEC_BT
        }
    }
    GRID_SYNC();

    {
        int tid_l; asm volatile("v_mov_b32 %0, %1" : "=v"(tid_l) : "v"(threadIdx.x));
        const int tid = tid_l, lane = tid & 63;
        const int ci = (G == 256) ? ((bx & 7) * 32 + (bx >> 3)) : bx;
        const int b = ci >> 7, c = ci & 127, t0 = c * TC, grow0 = b * SEQ + t0;
        const int q = lane >> 4, c15 = lane & 15;
        LAS unsigned char* T = lds;
        LAS unsigned char* PT = lds + PT_OFF;
        LAS float* SS = (LAS float*)(lds + SS_OFF);
        LAS float* CARRY = (LAS float*)(lds + CARRY_OFF);
        const bf16* Ub = U + (size_t)(b * SEQ) * DIN;
        const v4u vz = (v4u){0u, 0u, 0u, 0u};
        v4u cvr[11];
        {
            v4u pv[10];
#pragma unroll
            for (int i = 0; i < 10; ++i) { const int p = tid + 512 * i, r = p >> 6, c16 = p & 63, t = t0 - 15 + r;
                pv[i] = (r < 79 && t >= 0) ? *(const v4u*)(Ub + (size_t)(t < 0 ? 0 : t) * DIN + 1024 + c16 * 8) : vz; }
            { const int tb = t0 + 8 * wave; const bf16* ul = Ub + lane * 8;
#pragma unroll
              for (int i = 0; i < 11; ++i) { const int t = tb - 3 + i; cvr[i] = (t >= 0) ? *(const v4u*)(ul + (size_t)(t < 0 ? 0 : t) * DIN) : vz; } }
#pragma unroll
            for (int i = 0; i < 10; ++i) { const int p = tid + 512 * i, r = p >> 6, c16 = p & 63; if (r < 79) *(LAS v4u*)(PT + r * TSTR + c16 * 16) = pv[i]; }
        }
        float hl[4][4][4]; unsigned ppk[4][4][2];
        {
        {
            const int ch0 = lane * 8;
            f32x2 cw[4][4], cb[4];
#pragma unroll
            for (int k = 0; k < 4; ++k) { const f32x4 w0 = *(const f32x4*)(args.in[3] + k * LW + ch0), w1 = *(const f32x4*)(args.in[3] + k * LW + ch0 + 4);
                cw[k][0] = (f32x2){w0[0], w0[1]}; cw[k][1] = (f32x2){w0[2], w0[3]}; cw[k][2] = (f32x2){w1[0], w1[1]}; cw[k][3] = (f32x2){w1[2], w1[3]}; }
            { const f32x4 w0 = *(const f32x4*)(args.in[4] + ch0), w1 = *(const f32x4*)(args.in[4] + ch0 + 4); cb[0] = (f32x2){w0[0], w0[1]}; cb[1] = (f32x2){w0[2], w0[3]}; cb[2] = (f32x2){w1[0], w1[1]}; cb[3] = (f32x2){w1[2], w1[3]}; }
            f32x2 r0[4], r1[4], r2[4];
#define P2_UNPK(v, dst) do { dst[0] = (f32x2){bf_lo((v).x), bf_hi((v).x)}; dst[1] = (f32x2){bf_lo((v).y), bf_hi((v).y)}; dst[2] = (f32x2){bf_lo((v).z), bf_hi((v).z)}; dst[3] = (f32x2){bf_lo((v).w), bf_hi((v).w)}; } while (0)
            P2_UNPK(cvr[0], r0); P2_UNPK(cvr[1], r1); P2_UNPK(cvr[2], r2);
#pragma unroll
            for (int i = 0; i < 8; ++i) { f32x2 cv[4], xc[4]; P2_UNPK(cvr[3 + i], cv);
#pragma unroll
                for (int j = 0; j < 4; ++j) { xc[j] = cb[j] + cw[0][j] * r0[j] + cw[1][j] * r1[j] + cw[2][j] * r2[j] + cw[3][j] * cv[j]; r0[j] = r1[j]; r1[j] = r2[j]; r2[j] = cv[j]; }
                v4u o; o.x = pk2(xc[0].x, xc[0].y); o.y = pk2(xc[1].x, xc[1].y); o.z = pk2(xc[2].x, xc[2].y); o.w = pk2(xc[3].x, xc[3].y);
                *(LAS v4u*)(T + (8 * wave + i) * TSTR + ch0 * 2) = o; }
#undef P2_UNPK
        }
        __syncthreads();
        {
            const int h = wave;
            const int sa16 = ((lane - 16) & 63) * 4, sa32 = ((lane - 32) & 63) * 4, sa48 = (48 + c15) * 4;
#define P2_BP(addr, v) __int_as_float(__builtin_amdgcn_ds_bpermute((addr), __float_as_int(v)))
#pragma unroll
            for (int ctp = 0; ctp < 2; ++ctp) {
                asm volatile("" ::: "memory");
                bf16x8 fa[2][2], fx[2][2]; float bav[2], bxv[2], sp8[2], Pc[2], Hc[2]; int ch[2];
#pragma unroll
                for (int e = 0; e < 2; ++e) { const int ct = 2 * ctp + e; ch[e] = h * 64 + ct * 16 + c15;
                    const bf16* wa_ = WGA_t + h * 4096 + (ct * 16 + c15) * 64 + 8 * q; const bf16* wx_ = WGX_t + h * 4096 + (ct * 16 + c15) * 64 + 8 * q;
                    fa[e][0] = *(const bf16x8*)wa_; fa[e][1] = *(const bf16x8*)(wa_ + 32); fx[e][0] = *(const bf16x8*)wx_; fx[e][1] = *(const bf16x8*)(wx_ + 32);
                    bav[e] = args.in[6][ch[e]]; bxv[e] = args.in[8][ch[e]]; const float lam = args.in[9][ch[e]];
                    sp8[e] = 8.0f * (fmaxf(-lam, 0.f) + log1pf(__expf(-fabsf(lam)))); Pc[e] = 1.f; Hc[e] = 0.f; }
#pragma unroll
                for (int rt = 0; rt < 4; ++rt) {
                    asm volatile("" ::: "memory");
                    const LAS unsigned char* ap = T + (rt * 16 + c15) * TSTR + (h * 64 + 8 * q) * 2;
                    const bf16x8 a0 = *(const LAS bf16x8*)ap, a1 = *(const LAS bf16x8*)(ap + 64);
                    f32x4 ar[2], ai[2]; float P[2][4], H[2][4], Pi[2], Hi[2], Pe[2], He[2], Pt[2], Ht[2];
#pragma unroll
                    for (int e = 0; e < 2; ++e) { ar[e] = (f32x4){0.f, 0.f, 0.f, 0.f}; ai[e] = (f32x4){0.f, 0.f, 0.f, 0.f};
                        ar[e] = __builtin_amdgcn_mfma_f32_16x16x32_bf16(a0, fa[e][0], ar[e], 0, 0, 0); ai[e] = __builtin_amdgcn_mfma_f32_16x16x32_bf16(a0, fx[e][0], ai[e], 0, 0, 0); }
#pragma unroll
                    for (int e = 0; e < 2; ++e) { ar[e] = __builtin_amdgcn_mfma_f32_16x16x32_bf16(a1, fa[e][1], ar[e], 0, 0, 0); ai[e] = __builtin_amdgcn_mfma_f32_16x16x32_bf16(a1, fx[e][1], ai[e], 0, 0, 0); }
#pragma unroll
                    for (int e = 0; e < 2; ++e) {
                        float av[4], bbv[4];
                        const f32x2 nl2 = (f32x2){-1.44269504f, -1.44269504f}, one2 = (f32x2){1.0f, 1.0f};
                        const f32x2 bav2 = (f32x2){bav[e], bav[e]}, bxv2 = (f32x2){bxv[e], bxv[e]}, nsl2 = (f32x2){-sp8[e] * 1.44269504f, -sp8[e] * 1.44269504f};
#pragma unroll
                        for (int jp = 0; jp < 2; ++jp) { const int tl = rt * 16 + 4 * q + 2 * jp;
                            const f32x2 xcv = (f32x2){bf_s(*(const LAS unsigned short*)(T + tl * TSTR + ch[e] * 2)), bf_s(*(const LAS unsigned short*)(T + (tl + 1) * TSTR + ch[e] * 2))};
                            const f32x2 tr = ((f32x2){ar[e][2 * jp], ar[e][2 * jp + 1]} + bav2) * nl2, ti = ((f32x2){ai[e][2 * jp], ai[e][2 * jp + 1]} + bxv2) * nl2;
                            f32x2 er, ei; er.x = __builtin_amdgcn_exp2f(tr.x); er.y = __builtin_amdgcn_exp2f(tr.y); ei.x = __builtin_amdgcn_exp2f(ti.x); ei.y = __builtin_amdgcn_exp2f(ti.y);
                            const f32x2 dr = er + one2, di = ei + one2;
                            f32x2 r, ig; r.x = __builtin_amdgcn_rcpf(dr.x); r.y = __builtin_amdgcn_rcpf(dr.y); ig.x = __builtin_amdgcn_rcpf(di.x); ig.y = __builtin_amdgcn_rcpf(di.y);
                            const f32x2 la2 = r * nsl2;
                            f32x2 a; a.x = __builtin_amdgcn_exp2f(la2.x); a.y = __builtin_amdgcn_exp2f(la2.y);
                            const f32x2 om = one2 - a * a;
                            f32x2 mult; mult.x = __builtin_amdgcn_sqrtf(fmaxf(om.x, 1e-12f)); mult.y = __builtin_amdgcn_sqrtf(fmaxf(om.y, 1e-12f));
                            const f32x2 bb = (mult * ig) * xcv;
                            av[2 * jp] = a.x; av[2 * jp + 1] = a.y; bbv[2 * jp] = bb.x; bbv[2 * jp + 1] = bb.y; }
                        P[e][0] = av[0]; H[e][0] = bbv[0];
#pragma unroll
                        for (int j = 1; j < 4; ++j) { P[e][j] = av[j] * P[e][j - 1]; H[e][j] = av[j] * H[e][j - 1] + bbv[j]; } }
#pragma unroll
                    for (int e = 0; e < 2; ++e) { Pi[e] = P[e][3]; Hi[e] = H[e][3]; }
                    { float Pp[2], Hp[2];
#pragma unroll
                      for (int e = 0; e < 2; ++e) { Pp[e] = P2_BP(sa16, Pi[e]); Hp[e] = P2_BP(sa16, Hi[e]); }
#pragma unroll
                      for (int e = 0; e < 2; ++e) if (q >= 1) { Hi[e] = Pi[e] * Hp[e] + Hi[e]; Pi[e] = Pp[e] * Pi[e]; } }
                    { float Pp[2], Hp[2];
#pragma unroll
                      for (int e = 0; e < 2; ++e) { Pp[e] = P2_BP(sa32, Pi[e]); Hp[e] = P2_BP(sa32, Hi[e]); }
#pragma unroll
                      for (int e = 0; e < 2; ++e) if (q >= 2) { Hi[e] = Pi[e] * Hp[e] + Hi[e]; Pi[e] = Pp[e] * Pi[e]; } }
#pragma unroll
                    for (int e = 0; e < 2; ++e) { Pe[e] = P2_BP(sa16, Pi[e]); He[e] = P2_BP(sa16, Hi[e]); Pt[e] = P2_BP(sa48, Pi[e]); Ht[e] = P2_BP(sa48, Hi[e]); }
#pragma unroll
                    for (int e = 0; e < 2; ++e) { const int ct = 2 * ctp + e; if (q == 0) { Pe[e] = 1.f; He[e] = 0.f; }
                        const float Ppre = Pc[e] * Pe[e], Hpre = Pe[e] * Hc[e] + He[e];
#pragma unroll
                        for (int j = 0; j < 4; ++j) hl[ct][rt][j] = H[e][j] + P[e][j] * Hpre;
                        ppk[ct][rt][0] = pk2(P[e][0] * Ppre, P[e][1] * Ppre); ppk[ct][rt][1] = pk2(P[e][2] * Ppre, P[e][3] * Ppre);
                        asm volatile("" : "+v"(hl[ct][rt][0]), "+v"(hl[ct][rt][1]), "+v"(hl[ct][rt][2]), "+v"(hl[ct][rt][3]), "+v"(ppk[ct][rt][0]), "+v"(ppk[ct][rt][1]));
                        Hc[e] = Pt[e] * Hc[e] + Ht[e]; Pc[e] = Pc[e] * Pt[e]; }
                }
#pragma unroll
                for (int e = 0; e < 2; ++e) if (q == 0) agg[(size_t)ci * LW + ch[e]] = (f32x2){Pc[e], Hc[e]};
            }
#undef P2_BP
        }
        }
        sbx_arrive((unsigned*)(ws + WS_SB), gbar);
        {
            const int g = wave >> 1, th = wave & 1, ts = q, win = 2 << g, nh = th;
            const bf16* wp = WP_t + g * 16384 + (size_t)(nh * 64 + c15) * 128 + 8 * q;
            const int tl0 = th * 32 + ts * 8, tfirst = t0 + tl0;
            const LAS unsigned char* pp0 = PT + (tl0 + 15) * TSTR + (g * 128 + c15 * 8) * 2;
#define P2_UNPK4(v, dst) do { dst[0] = (f32x2){bf_lo((v).x), bf_hi((v).x)}; dst[1] = (f32x2){bf_lo((v).y), bf_hi((v).y)}; dst[2] = (f32x2){bf_lo((v).z), bf_hi((v).z)}; dst[3] = (f32x2){bf_lo((v).w), bf_hi((v).w)}; } while (0)
            f32x2 s[4];
#pragma unroll
            for (int j = 0; j < 4; ++j) s[j] = (f32x2){0.f, 0.f};
            for (int k = 1; k < win; ++k) { f32x2 cv[4]; const v4u lv = *(const LAS v4u*)(pp0 - k * TSTR); P2_UNPK4(lv, cv);
#pragma unroll
                for (int j = 0; j < 4; ++j) s[j] += cv[j]; }
#pragma unroll
            for (int i = 0; i < 8; ++i) { const int t = tfirst + i; f32x2 cv[4]; const v4u lv = *(const LAS v4u*)(pp0 + i * TSTR); P2_UNPK4(lv, cv);
                const float inv = 1.0f / (float)(t + 1 < win ? t + 1 : win); const f32x2 inv2 = (f32x2){inv, inv}; f32x2 p[4];
#pragma unroll
                for (int j = 0; j < 4; ++j) { s[j] += cv[j]; p[j] = s[j] * inv2 - cv[j]; }
                v4u o; o.x = pk2(p[0].x, p[0].y); o.y = pk2(p[1].x, p[1].y); o.z = pk2(p[2].x, p[2].y); o.w = pk2(p[3].x, p[3].y);
                *(LAS v4u*)(T + (tl0 + i) * TSTR + (g * 128 + c15 * 8) * 2) = o;
                f32x2 ov[4]; const v4u lo_ = *(const LAS v4u*)(pp0 + (i - win + 1) * TSTR); P2_UNPK4(lo_, ov);
#pragma unroll
                for (int j = 0; j < 4; ++j) s[j] -= ov[j]; }
#undef P2_UNPK4
            __syncthreads();
            f32x4 acc[4][4];
#pragma unroll
            for (int rt = 0; rt < 4; ++rt)
#pragma unroll
                for (int ct = 0; ct < 4; ++ct) acc[rt][ct] = (f32x4){0.f, 0.f, 0.f, 0.f};
            bf16x8 bfr[2][4];
#pragma unroll
            for (int ks = 0; ks < 4; ++ks) bfr[0][ks] = *(const bf16x8*)(wp + ks * 32);
#pragma unroll
            for (int ct = 0; ct < 4; ++ct) {
                asm volatile("" ::: "memory");
                if (ct < 3) {
#pragma unroll
                    for (int ks = 0; ks < 4; ++ks) bfr[(ct + 1) & 1][ks] = *(const bf16x8*)(wp + (ct + 1) * 2048 + ks * 32); }
#pragma unroll
                for (int rt = 0; rt < 4; ++rt)
#pragma unroll
                    for (int ks = 0; ks < 4; ++ks) { const bf16x8 a = *(const LAS bf16x8*)(T + (rt * 16 + c15) * TSTR + (g * 128 + ks * 32 + 8 * q) * 2);
                        acc[rt][ct] = __builtin_amdgcn_mfma_f32_16x16x32_bf16(bfr[ct & 1][ks], a, acc[rt][ct], 0, 0, 0); } }
            const int pc0 = g * 128 + nh * 64 + 4 * q;
            float ssq[4] = {0.f, 0.f, 0.f, 0.f};
#pragma unroll
            for (int ct = 0; ct < 4; ++ct) { const f32x4 pb = *(const f32x4*)(args.in[11] + pc0 + ct * 16), psc = *(const f32x4*)(args.in[12] + pc0 + ct * 16);
#pragma unroll
                for (int rt = 0; rt < 4; ++rt) { const f32x4 y = (acc[rt][ct] + pb) * psc; acc[rt][ct] = y; const f32x4 y2 = y * y; ssq[rt] += (y2[0] + y2[1]) + (y2[2] + y2[3]); } }
#pragma unroll
            for (int rt = 0; rt < 4; ++rt) { float v = ssq[rt]; v += __shfl_xor(v, 16); v += __shfl_xor(v, 32); if (q == 0) SS[(rt * 16 + c15) * 8 + wave] = v; }
            __syncthreads();
            float rstd[4];
#pragma unroll
            for (int rt = 0; rt < 4; ++rt) { const f32x4 s0 = *(const LAS f32x4*)(SS + (rt * 16 + c15) * 8), s1 = *(const LAS f32x4*)(SS + (rt * 16 + c15) * 8 + 4);
                rstd[rt] = __builtin_amdgcn_rsqf(((s0[0] + s0[1]) + (s0[2] + s0[3]) + (s1[0] + s1[1]) + (s1[2] + s1[3])) * (1.0f / 512.0f) + EPS); }
#pragma unroll
            for (int ct = 0; ct < 4; ++ct) {
#pragma unroll
                for (int rt = 0; rt < 4; ++rt) { const f32x4 y = acc[rt][ct] * rstd[rt]; v2u o; o.x = pk2(y[0], y[1]); o.y = pk2(y[2], y[3]);
                    *(LAS v2u*)(T + (rt * 16 + c15) * TSTR + (pc0 + ct * 16) * 2) = o; } }
            __syncthreads();
#pragma unroll
            for (int i = 0; i < 8; ++i) { const int p = tid + 512 * i, row = p >> 6, c16 = p & 63; const v4u v = *(const LAS v4u*)(T + row * TSTR + c16 * 16);
                pg8::st16(Y + (size_t)(grow0 + row) * D + 512 + c16 * 8, v); }
            __syncthreads();
        }
        sbx_wait((unsigned*)(ws + WS_SB), gbar);
        {
            const int h = wave;
            int tid_b; asm volatile("v_mov_b32 %0, %1" : "=v"(tid_b) : "v"(threadIdx.x));
            const int tid = tid_b, lane = tid & 63, q = lane >> 4, c15 = lane & 15;
            {
                LAS f32x2* SEG = (LAS f32x2*)PT;
                const f32x4* ag4 = (const f32x4*)(agg + (size_t)(b * 128) * LW) + lane;
#pragma unroll 1
                for (int kq = 0; kq < 4; ++kq) {
                    f32x4 v[16];
#pragma unroll
                    for (int i = 0; i < 16; ++i) { const int rw = 16 * wave + i, rc = rw < c ? rw : (c > 0 ? c - 1 : 0); v[i] = ag4[(size_t)rc * (LW / 2) + kq * 64]; }
                    f32x2 AA = (f32x2){1.f, 1.f}, BB = (f32x2){0.f, 0.f};
#pragma unroll
                    for (int i = 0; i < 16; ++i) { const bool on = (16 * wave + i) < c; const f32x2 a2 = on ? (f32x2){v[i][0], v[i][2]} : (f32x2){1.f, 1.f}, b2 = on ? (f32x2){v[i][1], v[i][3]} : (f32x2){0.f, 0.f};
                        BB = a2 * BB + b2; AA = AA * a2; }
                    *(LAS f32x4*)(SEG + wave * LW + kq * 128 + 2 * lane) = (f32x4){AA.x, BB.x, AA.y, BB.y};
                }
                asm volatile("" ::: "memory");
                { v4u gv8[8];
#pragma unroll
                  for (int i = 0; i < 8; ++i) { const int p = tid + 512 * i, row = p >> 6, c16 = p & 63; gv8[i] = *(const v4u*)(U + (size_t)(grow0 + row) * DIN + 512 + c16 * 8); }
#pragma unroll
                  for (int i = 0; i < 8; ++i) { const int p = tid + 512 * i, row = p >> 6, c16 = p & 63; *(LAS v4u*)(T + row * TSTR + c16 * 16) = gv8[i]; } }
                __syncthreads();
                float carry = 0.f;
#pragma unroll
                for (int w = 0; w < 8; ++w) { const f32x2 sg = SEG[w * LW + tid]; carry = sg.x * carry + sg.y; }
                CARRY[tid] = carry;
            }
            __syncthreads();
            float ss[4][4];
#pragma unroll
            for (int rt = 0; rt < 4; ++rt)
#pragma unroll
                for (int j = 0; j < 4; ++j) ss[rt][j] = 0.f;
#pragma unroll
            for (int ct = 0; ct < 4; ++ct) { asm volatile("" ::: "memory"); const int ch = h * 64 + ct * 16 + c15; const float cr = CARRY[ch];
#pragma unroll
                for (int rt = 0; rt < 4; ++rt)
#pragma unroll
                    for (int jp = 0; jp < 2; ++jp) { const int tl = rt * 16 + 4 * q + 2 * jp;
                        const f32x2 ug = (f32x2){bf_s(*(const LAS unsigned short*)(T + tl * TSTR + ch * 2)), bf_s(*(const LAS unsigned short*)(T + (tl + 1) * TSTR + ch * 2))};
                        const f32x2 ppv = (f32x2){bf_lo(ppk[ct][rt][jp]), bf_hi(ppk[ct][rt][jp])}, crv = (f32x2){cr, cr};
                        const f32x2 hf = (f32x2){hl[ct][rt][2 * jp], hl[ct][rt][2 * jp + 1]} + ppv * crv;
                        const f32x2 y = hf * ug, y2 = y * y;
                        hl[ct][rt][2 * jp] = y.x; hl[ct][rt][2 * jp + 1] = y.y; ss[rt][2 * jp] += y2.x; ss[rt][2 * jp + 1] += y2.y; } }
            {
                float w8[8], w4[4], w2[2];
                const bool b3 = (lane & 8) != 0, b2 = (lane & 4) != 0, b1 = (lane & 2) != 0, b0 = (lane & 1) != 0;
#pragma unroll
                for (int k = 0; k < 8; ++k) { const float lo = ss[k >> 2][k & 3], hi = ss[2 + (k >> 2)][k & 3]; const float keep = b3 ? hi : lo, send = b3 ? lo : hi; w8[k] = keep + __shfl_xor(send, 8); }
#pragma unroll
                for (int k = 0; k < 4; ++k) { const float keep = b2 ? w8[k + 4] : w8[k], send = b2 ? w8[k] : w8[k + 4]; w4[k] = keep + __shfl_xor(send, 4); }
#pragma unroll
                for (int k = 0; k < 2; ++k) { const float keep = b1 ? w4[k + 2] : w4[k], send = b1 ? w4[k] : w4[k + 2]; w2[k] = keep + __shfl_xor(send, 2); }
                const float keep = b0 ? w2[1] : w2[0], send = b0 ? w2[0] : w2[1]; const float tot = keep + __shfl_xor(send, 1);
                SS[((c15 >> 2) * 16 + 4 * q + (c15 & 3)) * 8 + h] = tot;
            }
            __syncthreads();
#pragma unroll
            for (int rt = 0; rt < 4; ++rt)
#pragma unroll
                for (int j = 0; j < 4; ++j) { const int tl = rt * 16 + 4 * q + j; const f32x4 s0 = *(const LAS f32x4*)(SS + tl * 8), s1 = *(const LAS f32x4*)(SS + tl * 8 + 4);
                    ss[rt][j] = __builtin_amdgcn_rsqf(((s0[0] + s0[1]) + (s0[2] + s0[3]) + (s1[0] + s1[1]) + (s1[2] + s1[3])) * (1.0f / 512.0f) + EPS); }
#pragma unroll
            for (int ct = 0; ct < 4; ++ct) { asm volatile("" ::: "memory"); const int ch = h * 64 + ct * 16 + c15;
#pragma unroll
                for (int rt = 0; rt < 4; ++rt)
#pragma unroll
                    for (int jp = 0; jp < 2; ++jp) { const int tl = rt * 16 + 4 * q + 2 * jp;
                        const f32x2 v = (f32x2){hl[ct][rt][2 * jp], hl[ct][rt][2 * jp + 1]} * (f32x2){ss[rt][2 * jp], ss[rt][2 * jp + 1]};
                        const unsigned pw = pk2(v.x, v.y);
                        *(LAS unsigned short*)(T + tl * TSTR + ch * 2) = (unsigned short)(pw & 0xffffu); *(LAS unsigned short*)(T + (tl + 1) * TSTR + ch * 2) = (unsigned short)(pw >> 16); } }
            __syncthreads();
#pragma unroll
            for (int i = 0; i < 8; ++i) { const int p = tid + 512 * i, row = p >> 6, c16 = p & 63; const v4u v = *(const LAS v4u*)(T + row * TSTR + c16 * 16);
                pg8::st16(Y + (size_t)(grow0 + row) * D + c16 * 8, v); }
        }
    }
    GRID_SYNC();

    {
        pg8::Gemm g{Y, Wout_t, M, D, D, 1}; pg8::StaticOrder S; S.init(M, D, G, bx);
        pg8::EpiRes3 E{x, H1B, rowss1};
        pg8::gemm_phase<pg8::EpiRes3, pg8::StaticOrder, true, true>(lds, g, S, E);
    }
    GRID_SYNC();

    {
        pg8::Gemm g{H1B, W13_t, M, N13, D, 1}; pg8::TailSplitOrder S; S.init(M, N13, G, bx);
        pg8::EpiFfn E{HB, rowss1};
        pg8::gemm_phase<pg8::EpiFfn, pg8::TailSplitOrder, true, true>(lds, g, S, E);
    }
    GRID_SYNC();

    {
        pg8::Gemm g{HB, W2_t, M, D, FF, 1}; pg8::StaticOrder S; S.init(M, D, G, bx);
        pg8::EpiFinal E{H1B, out, args.in[20], (float*)(ws + WS_AGG), (unsigned*)(ws + WS_CNT)};
        pg8::gemm_phase<pg8::EpiFinal, pg8::StaticOrder, false, true>(lds, g, S, E);
    }
}

extern "C" void kernel_launch(void* const* d_in, const int* in_sizes, int n_in, void* d_out, int out_size, void* d_ws, size_t ws_size, hipStream_t stream) {
    static int grid = 0;
    if (grid == 0) {
        if (n_in != 21 || out_size != M * D || ws_size < WS_END) { fprintf(stderr, "kernel_launch: unexpected shapes n_in %d out %d ws %zu\n", n_in, out_size, ws_size); grid = -1; return; }
        int dev = 0, cus = 0, per_cu = 0;
        (void)hipGetDevice(&dev); (void)hipDeviceGetAttribute(&cus, hipDeviceAttributeMultiprocessorCount, dev);
        if (hipFuncSetAttribute((const void*)fwd_mega, hipFuncAttributeMaxDynamicSharedMemorySize, LDS_BYTES) != hipSuccess) { fprintf(stderr, "kernel_launch: hipFuncSetAttribute failed\n"); grid = -1; return; }
        (void)hipOccupancyMaxActiveBlocksPerMultiprocessor(&per_cu, (const void*)fwd_mega, NWAVES * 64, LDS_BYTES);
        (void)hipGetLastError();
        if (cus * per_cu < 256) fprintf(stderr, "kernel_launch: co-resident capacity %d x %d < 256 workgroups\n", cus, per_cu);
        grid = 256;
    }
    if (grid < 0) return;
    Args a{};
    for (int i = 0; i < 21; ++i) a.in[i] = (const float*)d_in[i];
    a.out = (float*)d_out; a.ws = (unsigned char*)d_ws;
    if (hipMemsetAsync((char*)d_ws + WS_BAR, 0, BAR_BYTES, stream) != hipSuccess) { fprintf(stderr, "kernel_launch: hipMemsetAsync failed\n"); return; }
    void* kargs[] = {&a};
    hipError_t e = hipLaunchCooperativeKernel((const void*)fwd_mega, dim3(grid), dim3(NWAVES * 64), kargs, LDS_BYTES, stream);
    if (e != hipSuccess) fprintf(stderr, "kernel_launch: cooperative launch failed: %s\n", hipGetErrorString(e));
}
```

```cpp
#define WGM_P1 4
#define WGM_P3 8
#define WGM_P4 4
#define WGM_P5 8
#include <hip/hip_runtime.h>
#include <hip/hip_cooperative_groups.h>
#include <cstdio>
#include <cstdint>
namespace cg = cooperative_groups;
namespace pg8 {
#define PG8_LAS __attribute__((address_space(3)))
typedef unsigned short bf16_t;
typedef short bf16x8 __attribute__((ext_vector_type(8)));
typedef float f32x4 __attribute__((ext_vector_type(4)));
typedef unsigned u32x4 __attribute__((ext_vector_type(4)));
constexpr int BM = 256, BK = 64, HALF = 128, HTB = HALF * BK * 2  , STAGE_BYTES = 8 * HTB, NXCD = 8, WGM = 8;

__host__ __device__ __forceinline__ int lds_byte(int r, int c) { const int st = (r >> 4) * 2 + (c >> 5), rr = r & 15, cc = c & 31, ob = rr * 64 + cc * 2; return st * 1024 + (ob ^ (((ob >> 9) & 1) << 5)); }
__host__ __device__ __forceinline__ void stage_rc(int b, int& R, int& C) { const int st = b / 1024, sb = b % 1024, swz = sb ^ (((sb >> 9) & 1) << 5); R = (st >> 1) * 16 + swz / 64; C = (st & 1) * 32 + (swz % 64) / 2; }
__host__ __device__ __forceinline__ int perm32(int rho) { const int n = rho >> 4, i = rho & 15; return 8 * (i >> 2) + 4 * n + (i & 3); }

struct Unit { int pm, pn, half; };
struct Gemm { const bf16_t* A; const bf16_t* Bt; int M, N, K, btiled; };

struct StaticOrder {
    int nM, nN, nwg, G, c, wgm;
    __host__ __device__ void init(int M, int N, int G_, int c_, int wgm_ = WGM) { nM = M / BM; nN = N / BM; nwg = nM * nN; G = G_; c = c_; wgm = wgm_; }
    __host__ __device__ bool next(int i, Unit& u) const {
        const long L = (long)i * G + c; if (L >= nwg) return false;
        int wgid = (int)L; { const int q = nwg / NXCD, r = nwg % NXCD, xcd = wgid % NXCD, off = wgid / NXCD; wgid = (xcd < r ? xcd * (q + 1) : r * (q + 1) + (xcd - r) * q) + off; }
        const int nig = wgm * nN, gid = wgid / nig, fm = gid * wgm, gsz = (nM - fm) < wgm ? (nM - fm) : wgm;
        u.pm = fm + ((wgid % nig) % gsz); u.pn = (wgid % nig) / gsz; u.half = 0; return true;
    }
    __device__ __forceinline__ void a_ready(const Unit&) const {}
    __device__ __forceinline__ void done(const Unit&) const {}
};

struct TailSplitOrder : StaticOrder {
    __host__ __device__ bool next(int i, Unit& u) const {
        const int R = nwg / G;
        if (i < R) return StaticOrder::next(i, u);
        if (i > R || (nwg - R * G) * 2 != G) return (i == R) ? StaticOrder::next(i, u) : false;
        StaticOrder t = *this; t.c = 0; t.G = 1;
        if (!t.next(R * G + (c >> 1), u)) return false;
        u.half = 1 + (c & 1); return true;
    }
};

__device__ __forceinline__ unsigned cvt_pk_bf16(float lo, float hi) { unsigned r; asm volatile("v_cvt_pk_bf16_f32 %0, %1, %2" : "=v"(r) : "v"(lo), "v"(hi)); return r; }
typedef float f32x2 __attribute__((ext_vector_type(2)));
#ifndef WT_STORES
#define WT_STORES 0
#endif
__device__ __forceinline__ void st16(void* p, u32x4 v) {
#if WT_STORES
    asm volatile("global_store_dwordx4 %0, %1, off sc1\n\ts_nop 1" :: "v"(p), "v"(v) : "memory");
#else
    *(u32x4*)p = v;
#endif
}
struct EpiU {
    static constexpr bool PERM = true, AFTER_DRAIN = false, HAS_PRE = false;
    bf16_t* O; int ldc;
    static __device__ __forceinline__ f32x2 gelu2(f32x2 v) {
        const f32x2 c0 = (f32x2){-2.302208198f, -2.302208198f}, c1 = (f32x2){0.044715f * -2.302208198f, 0.044715f * -2.302208198f}, one = (f32x2){1.0f, 1.0f};
        const f32x2 z = v * ((v * v) * c1 + c0); f32x2 e; e.x = __builtin_amdgcn_exp2f(z.x); e.y = __builtin_amdgcn_exp2f(z.y);
        const f32x2 d = e + one; f32x2 r; r.x = __builtin_amdgcn_rcpf(d.x); r.y = __builtin_amdgcn_rcpf(d.y); return v * r;
    }
    __device__ __forceinline__ void operator()(const f32x4 (&acc)[2][2][4][2], const Unit& u, int wr, int wc, int fr, int fq) const {
        const int row0 = u.pm * BM + wr * 64 + fr, col0 = u.pn * BM + wc * 32 + 8 * fq;
        const bool gate = (u.pn == 2) || (u.pn == 3);
#pragma unroll
        for (int ai = 0; ai < 2; ++ai)
#pragma unroll
            for (int m = 0; m < 4; ++m) { bf16_t* rowp = O + (size_t)(row0 + ai * HALF + m * 16) * ldc + col0;
#pragma unroll
                for (int bj = 0; bj < 2; ++bj) { f32x4 v0 = acc[ai][bj][m][0], v1 = acc[ai][bj][m][1];
                    if (gate) { const f32x2 a = gelu2((f32x2){v0[0], v0[1]}), b = gelu2((f32x2){v0[2], v0[3]}), c = gelu2((f32x2){v1[0], v1[1]}), d = gelu2((f32x2){v1[2], v1[3]});
                        v0 = (f32x4){a.x, a.y, b.x, b.y}; v1 = (f32x4){c.x, c.y, d.x, d.y}; }
                    u32x4 w; w.x = cvt_pk_bf16(v0[0], v0[1]); w.y = cvt_pk_bf16(v0[2], v0[3]); w.z = cvt_pk_bf16(v1[0], v1[1]); w.w = cvt_pk_bf16(v1[2], v1[3]);
                    st16(rowp + bj * HALF, w); } }
    }
};
template <bool WB> struct EpiRes {
    static constexpr bool PERM = true, AFTER_DRAIN = false, HAS_PRE = false;
    const float* base; float* out; bf16_t* ob; float* rowss;
    __device__ __forceinline__ void operator()(const f32x4 (&acc)[2][2][4][2], const Unit& u, int wr, int wc, int fr, int fq) const {
        const int row0 = u.pm * BM + wr * 64 + fr, col0 = u.pn * BM + wc * 32 + 8 * fq;
#pragma unroll
        for (int ai = 0; ai < 2; ++ai) {
            f32x4 bv[4][2][2];
#pragma unroll
            for (int m = 0; m < 4; ++m)
#pragma unroll
                for (int bj = 0; bj < 2; ++bj) { const float* p = base + (size_t)(row0 + ai * HALF + m * 16) * 1024 + col0 + bj * HALF; bv[m][bj][0] = *(const f32x4*)p; bv[m][bj][1] = *(const f32x4*)(p + 4); }
#pragma unroll
            for (int m = 0; m < 4; ++m) { const int row = row0 + ai * HALF + m * 16; const size_t off = (size_t)row * 1024 + col0; float ss = 0.f;
#pragma unroll
                for (int bj = 0; bj < 2; ++bj) { const size_t p = off + bj * HALF;
                    const f32x4 v0 = acc[ai][bj][m][0] + bv[m][bj][0], v1 = acc[ai][bj][m][1] + bv[m][bj][1];
                    *(f32x4*)(out + p) = v0; *(f32x4*)(out + p + 4) = v1;
                    { const f32x4 sq4 = v0 * v0 + v1 * v1; ss += (sq4[0] + sq4[1]) + (sq4[2] + sq4[3]); }
                    if (WB) { u32x4 w; w.x = cvt_pk_bf16(v0[0], v0[1]); w.y = cvt_pk_bf16(v0[2], v0[3]); w.z = cvt_pk_bf16(v1[0], v1[1]); w.w = cvt_pk_bf16(v1[2], v1[3]); *(u32x4*)(ob + p) = w; } }
                ss += __shfl_xor(ss, 16); ss += __shfl_xor(ss, 32);
                if (fq == 0) unsafeAtomicAdd(rowss + row, ss); }
            asm volatile("" ::: "memory"); }
    }
};
struct EpiRes3 {
    static constexpr bool PERM = true, AFTER_DRAIN = false, HAS_PRE = false;
    const float* base; bf16_t* ob; float* rowss;
    __device__ __forceinline__ void operator()(const f32x4 (&acc)[2][2][4][2], const Unit& u, int wr, int wc, int fr, int fq) const {
        const int row0 = u.pm * BM + wr * 64 + fr, col0 = u.pn * BM + wc * 32 + 8 * fq;
#pragma unroll
        for (int ai = 0; ai < 2; ++ai) {
            f32x4 bv[4][2][2];
#pragma unroll
            for (int m = 0; m < 4; ++m)
#pragma unroll
                for (int bj = 0; bj < 2; ++bj) { const float* p = base + (size_t)(row0 + ai * HALF + m * 16) * 1024 + col0 + bj * HALF; bv[m][bj][0] = *(const f32x4*)p; bv[m][bj][1] = *(const f32x4*)(p + 4); }
#pragma unroll
            for (int m = 0; m < 4; ++m) { const int row = row0 + ai * HALF + m * 16; const size_t off = (size_t)row * 1024 + col0; float ss = 0.f;
#pragma unroll
                for (int bj = 0; bj < 2; ++bj) { const size_t p = off + bj * HALF;
                    const f32x4 v0 = acc[ai][bj][m][0] + bv[m][bj][0], v1 = acc[ai][bj][m][1] + bv[m][bj][1];
                    { const f32x4 sq4 = v0 * v0 + v1 * v1; ss += (sq4[0] + sq4[1]) + (sq4[2] + sq4[3]); }
                    u32x4 w; w.x = cvt_pk_bf16(v0[0], v0[1]); w.y = cvt_pk_bf16(v0[2], v0[3]); w.z = cvt_pk_bf16(v1[0], v1[1]); w.w = cvt_pk_bf16(v1[2], v1[3]); st16(ob + p, w); }
                ss += __shfl_xor(ss, 16); ss += __shfl_xor(ss, 32);
                if (fq == 0) unsafeAtomicAdd(rowss + row, ss); }
            asm volatile("" ::: "memory"); }
    }
};
struct EpiRes5 {
    static constexpr bool PERM = true, AFTER_DRAIN = false, HAS_PRE = false;
    const bf16_t* hb; float* out; float* rowss;
    __device__ __forceinline__ void operator()(const f32x4 (&acc)[2][2][4][2], const Unit& u, int wr, int wc, int fr, int fq) const {
        const int row0 = u.pm * BM + wr * 64 + fr, col0 = u.pn * BM + wc * 32 + 8 * fq;
#pragma unroll
        for (int ai = 0; ai < 2; ++ai) {
            u32x4 bv[4][2];
#pragma unroll
            for (int m = 0; m < 4; ++m)
#pragma unroll
                for (int bj = 0; bj < 2; ++bj) bv[m][bj] = *(const u32x4*)(hb + (size_t)(row0 + ai * HALF + m * 16) * 1024 + col0 + bj * HALF);
#pragma unroll
            for (int m = 0; m < 4; ++m) { const int row = row0 + ai * HALF + m * 16; const size_t off = (size_t)row * 1024 + col0; float ss = 0.f;
#pragma unroll
                for (int bj = 0; bj < 2; ++bj) { const size_t p = off + bj * HALF; const u32x4 h = bv[m][bj];
                    const f32x4 r0 = (f32x4){__uint_as_float(h.x << 16), __uint_as_float(h.x & 0xffff0000u), __uint_as_float(h.y << 16), __uint_as_float(h.y & 0xffff0000u)};
                    const f32x4 r1 = (f32x4){__uint_as_float(h.z << 16), __uint_as_float(h.z & 0xffff0000u), __uint_as_float(h.w << 16), __uint_as_float(h.w & 0xffff0000u)};
                    const f32x4 v0 = acc[ai][bj][m][0] + r0, v1 = acc[ai][bj][m][1] + r1;
                    *(f32x4*)(out + p) = v0; *(f32x4*)(out + p + 4) = v1;
                    { const f32x4 sq4 = v0 * v0 + v1 * v1; ss += (sq4[0] + sq4[1]) + (sq4[2] + sq4[3]); } }
                ss += __shfl_xor(ss, 16); ss += __shfl_xor(ss, 32);
                if (fq == 0) unsafeAtomicAdd(rowss + row, ss); }
            asm volatile("" ::: "memory"); }
    }
};
struct EpiFinal {
    static constexpr bool PERM = true, AFTER_DRAIN = true, HAS_PRE = false;
    const bf16_t* hb; float* out; const float* gfin; float* xbuf; unsigned* cnt;
    __device__ __forceinline__ void preload(const Unit& u, int wr, int wc, int fr, int fq, u32x4 (&pbv)[2][4][2]) const {
        const int row0 = u.pm * BM + wr * 64 + fr, col0 = u.pn * BM + wc * 32 + 8 * fq;
#pragma unroll
        for (int ai = 0; ai < 2; ++ai)
#pragma unroll
            for (int m = 0; m < 4; ++m)
#pragma unroll
                for (int bj = 0; bj < 2; ++bj) pbv[ai][m][bj] = *(const u32x4*)(hb + (size_t)(row0 + ai * HALF + m * 16) * 1024 + col0 + bj * HALF);
    }
    __device__ __forceinline__ void fused(f32x4 (&acc)[2][2][4][2], const Unit& u, int wr, int wc, int fr, int fq, PG8_LAS unsigned char* lds, int wid, int lane, const u32x4 (&pbv)[2][4][2]) const {
        PG8_LAS float* P = (PG8_LAS float*)lds;
        PG8_LAS float* S = (PG8_LAS float*)(lds + 4096);
        const int row0 = u.pm * BM + wr * 64 + fr, col0 = u.pn * BM + wc * 32 + 8 * fq;
#pragma unroll
        for (int ai = 0; ai < 2; ++ai) {
#pragma unroll
            for (int m = 0; m < 4; ++m) { float ss = 0.f;
#pragma unroll
                for (int bj = 0; bj < 2; ++bj) { const u32x4 h = pbv[ai][m][bj];
                    const f32x4 r0 = (f32x4){__uint_as_float(h.x << 16), __uint_as_float(h.x & 0xffff0000u), __uint_as_float(h.y << 16), __uint_as_float(h.y & 0xffff0000u)};
                    const f32x4 r1 = (f32x4){__uint_as_float(h.z << 16), __uint_as_float(h.z & 0xffff0000u), __uint_as_float(h.w << 16), __uint_as_float(h.w & 0xffff0000u)};
                    const f32x4 v0 = acc[ai][bj][m][0] + r0, v1 = acc[ai][bj][m][1] + r1; acc[ai][bj][m][0] = v0; acc[ai][bj][m][1] = v1;
                    { const f32x4 sq4 = v0 * v0 + v1 * v1; ss += (sq4[0] + sq4[1]) + (sq4[2] + sq4[3]); } }
                ss += __shfl_xor(ss, 16); ss += __shfl_xor(ss, 32);
                if (fq == 0) P[(ai * HALF + wr * 64 + m * 16 + fr) * 4 + wc] = ss; }
            asm volatile("" ::: "memory"); }
        asm volatile("s_waitcnt lgkmcnt(0)" ::: "memory"); __builtin_amdgcn_s_barrier(); asm volatile("" ::: "memory");
        const int row = wid * 32 + (lane & 31);
        if (lane < 32) { const f32x4 p = *(const PG8_LAS f32x4*)(P + row * 4);
            __hip_atomic_store(xbuf + ((size_t)(u.pm * BM + row) * 4 + u.pn), (p[0] + p[1]) + (p[2] + p[3]), __ATOMIC_RELAXED, __HIP_MEMORY_SCOPE_AGENT); }
        asm volatile("s_waitcnt vmcnt(0)" ::: "memory");
        if (lane == 0) __hip_atomic_fetch_add(cnt + 64 * u.pm, 1u, __ATOMIC_RELAXED, __HIP_MEMORY_SCOPE_AGENT);
        if (wid == 0) { unsigned sp = 0;
            while ((unsigned)__builtin_amdgcn_readfirstlane(__hip_atomic_load(cnt + 64 * u.pm, __ATOMIC_RELAXED, __HIP_MEMORY_SCOPE_AGENT)) < 32u) { __builtin_amdgcn_s_sleep(2); if (++sp > (1u << 20)) break; }
            __builtin_amdgcn_fence(__ATOMIC_ACQUIRE, "agent"); }
        asm volatile("s_waitcnt vmcnt(0) lgkmcnt(0)" ::: "memory"); __builtin_amdgcn_s_barrier(); asm volatile("" ::: "memory");
        if (lane < 32) { const float* slot = xbuf + (size_t)(u.pm * BM + row) * 4; float t = 0.f;
#pragma unroll
            for (int k = 0; k < 4; ++k) t += __hip_atomic_load(slot + k, __ATOMIC_RELAXED, __HIP_MEMORY_SCOPE_AGENT);
            S[row] = __builtin_amdgcn_rsqf(t * (1.0f / 1024.0f) + 1e-6f); }
        asm volatile("s_waitcnt vmcnt(0) lgkmcnt(0)" ::: "memory"); __builtin_amdgcn_s_barrier(); asm volatile("" ::: "memory");
        f32x4 gv[2][2];
#pragma unroll
        for (int bj = 0; bj < 2; ++bj) { gv[bj][0] = *(const f32x4*)(gfin + col0 + bj * HALF); gv[bj][1] = *(const f32x4*)(gfin + col0 + bj * HALF + 4); }
#pragma unroll
        for (int ai = 0; ai < 2; ++ai)
#pragma unroll
            for (int m = 0; m < 4; ++m) { const int r = ai * HALF + wr * 64 + m * 16 + fr; const float rs = S[r]; float* op = out + (size_t)(u.pm * BM + r) * 1024 + col0;
#pragma unroll
                for (int bj = 0; bj < 2; ++bj) { *(f32x4*)(op + bj * HALF) = acc[ai][bj][m][0] * rs * gv[bj][0]; *(f32x4*)(op + bj * HALF + 4) = acc[ai][bj][m][1] * rs * gv[bj][1]; } }
    }
};
struct EpiFfn {
    static constexpr bool PERM = true, AFTER_DRAIN = false, HAS_PRE = true;
    bf16_t* O; const float* rowss;
    __device__ __forceinline__ void prefetch(const Unit& u, int wr, int wc, int fr, int fq, float (&pre)[8]) const {
        const int row0 = u.pm * BM + (u.half == 2 ? HALF : 0) + wr * 64 + fr;
#pragma unroll
        for (int ai = 0; ai < 2; ++ai)
#pragma unroll
            for (int m = 0; m < 4; ++m) pre[ai * 4 + m] = rowss[row0 + ai * HALF + m * 16];
    }
    __device__ __forceinline__ void operator()(const f32x4 (&acc)[2][2][4][2], const Unit& u, int wr, int wc, int fr, int fq, const float (&pre)[8]) const {
        const int row0 = u.pm * BM + (u.half == 2 ? HALF : 0) + wr * 64 + fr, col0 = u.pn * HALF + wc * 32 + 8 * fq;
#pragma unroll
        for (int ai = 0; ai < 2; ++ai) { if (ai == 1 && u.half != 0) break;
#pragma unroll
            for (int m = 0; m < 4; ++m) { const int row = row0 + ai * HALF + m * 16; const float rstd = __builtin_amdgcn_rsqf(pre[ai * 4 + m] * (1.0f / 1024.0f) + 1e-6f);
                const float r2 = rstd * rstd, nrl = rstd * -1.44269504f;
                const f32x2 r2v = (f32x2){r2, r2}, nrlv = (f32x2){nrl, nrl}, onev = (f32x2){1.0f, 1.0f};
                f32x2 fp[4];
#pragma unroll
                for (int n = 0; n < 2; ++n)
#pragma unroll
                    for (int hh = 0; hh < 2; ++hh) { const f32x4 a4 = acc[ai][0][m][n], b4 = acc[ai][1][m][n];
                        const f32x2 a = hh ? (f32x2){a4[2], a4[3]} : (f32x2){a4[0], a4[1]}, b = hh ? (f32x2){b4[2], b4[3]} : (f32x2){b4[0], b4[1]};
                        const f32x2 t = a * nrlv; f32x2 e; e.x = __builtin_amdgcn_exp2f(t.x); e.y = __builtin_amdgcn_exp2f(t.y);
                        const f32x2 d = e + onev; f32x2 sg; sg.x = __builtin_amdgcn_rcpf(d.x); sg.y = __builtin_amdgcn_rcpf(d.y);
                        fp[n * 2 + hh] = ((a * b) * r2v) * sg; }
                u32x4 w; w.x = cvt_pk_bf16(fp[0].x, fp[0].y); w.y = cvt_pk_bf16(fp[1].x, fp[1].y); w.z = cvt_pk_bf16(fp[2].x, fp[2].y); w.w = cvt_pk_bf16(fp[3].x, fp[3].y);
                st16(O + (size_t)row * 2816 + col0, w); } }
    }
};

template <class Epi, class Sched, bool ALIGN_EPI = false, bool SP2 = false>
__device__ __forceinline__ void gemm_phase(PG8_LAS unsigned char* lds, const Gemm g, const Sched& S, const Epi& E) {
    int tid_l; asm volatile("v_mov_b32 %0, %1" : "=v"(tid_l) : "v"(threadIdx.x));
    const int tid = tid_l, wid = __builtin_amdgcn_readfirstlane(tid >> 6), lane = tid & 63, wr = wid >> 2, wc = wid & 3, fr = lane & 15, fq = lane >> 4;
    const int K = g.K, nt = K / BK;
    unsigned voffA[2], voffB[2];
#pragma unroll
    for (int i = 0; i < 2; ++i) { int R, C; stage_rc(tid * 16 + i * 8192, R, C); const int Rb = Epi::PERM ? ((R & ~31) + perm32(R & 31)) : R;
        voffA[i] = (unsigned)(R * K + C) * 2u; voffB[i] = (unsigned)(Rb * (g.btiled ? BK : K) + C) * 2u; }
    const size_t kstep = (size_t)(BK * 2);
    const size_t hstep = (size_t)HALF * K * 2;
    const size_t tstep = 2 * hstep; const size_t kstepB = g.btiled ? (size_t)(BM * BK * 2) : kstep, hstepB = g.btiled ? (size_t)(HALF * BK * 2) : hstep;
    const unsigned ldsw = (unsigned)wid * 1024u;
    const int aoff = lds_byte(wr * 64 + fr, fq * 8), boff = lds_byte(wc * 32 + fr, fq * 8);
#define PG8_SA(b, h) (((b) * 2 + (h)) * HTB)
#define PG8_SB(b, h) ((4 + (b) * 2 + (h)) * HTB)
#define PG8_STAGE(bufoff, gbase, voff) do { _Pragma("unroll") for (int _i = 0; _i < 2; ++_i) \
        __builtin_amdgcn_global_load_lds((const unsigned*)((const char*)(gbase) + (voff)[_i]), (PG8_LAS unsigned*)(lds + (bufoff) + ldsw + _i * 8192), 16, 0, 0); } while (0)
#define PG8_LDA(dst, b, h) do { _Pragma("unroll") for (int m = 0; m < 4; ++m) _Pragma("unroll") for (int k = 0; k < 2; ++k) dst[m][k] = *(const PG8_LAS bf16x8*)(lds + PG8_SA(b, h) + aoff + m * 2048 + k * 1024); } while (0)
#define PG8_LDB(dst, b, h) do { _Pragma("unroll") for (int n = 0; n < 2; ++n) _Pragma("unroll") for (int k = 0; k < 2; ++k) dst[n][k] = *(const PG8_LAS bf16x8*)(lds + PG8_SB(b, h) + boff + n * 2048 + k * 1024); } while (0)
#define PG8_MMA(ai, bj, At, Bt) do { __builtin_amdgcn_s_setprio(1); _Pragma("unroll") for (int m = 0; m < 4; ++m) _Pragma("unroll") for (int n = 0; n < 2; ++n) _Pragma("unroll") for (int k = 0; k < 2; ++k) \
        acc[ai][bj][m][n] = __builtin_amdgcn_mfma_f32_16x16x32_bf16(Bt[n][k], At[m][k], acc[ai][bj][m][n], 0, 0, 0); __builtin_amdgcn_s_setprio(0); } while (0)
#define PG8_WAIT_V(n) asm volatile("s_waitcnt vmcnt(" #n ")" ::: "memory")
#define PG8_WAIT_L(n) asm volatile("s_waitcnt lgkmcnt(" #n ")" ::: "memory")
#define PG8_BAR __builtin_amdgcn_s_barrier()
#define PG8_SCHED __builtin_amdgcn_sched_barrier(0)
    Unit cur, nxt; int ui = 0;
    if (!S.next(0, cur)) return;
    f32x4 acc[2][2][4][2];
#pragma unroll
    for (int a = 0; a < 2; ++a)
#pragma unroll
        for (int b = 0; b < 2; ++b)
#pragma unroll
            for (int m = 0; m < 4; ++m)
#pragma unroll
                for (int n = 0; n < 2; ++n) acc[a][b][m][n] = (f32x4){0.f, 0.f, 0.f, 0.f};
    bf16x8 At[4][2], B0[2][2], B1[2][2];
    const char* cA = (const char*)g.A + (size_t)cur.pm * tstep + (cur.half == 2 ? hstep : (size_t)0); const char* cB = (const char*)g.Bt + (size_t)cur.pn * tstep;
    float pre[8];
    if constexpr (Epi::HAS_PRE) E.prefetch(cur, wr, wc, fr, fq, pre);
    S.a_ready(cur);
    if constexpr (SP2) {
        PG8_STAGE(PG8_SB(0, 0), cB, voffB); PG8_STAGE(PG8_SB(0, 1), cB + hstepB, voffB); PG8_STAGE(PG8_SA(0, 0), cA, voffA); PG8_STAGE(PG8_SA(0, 1), cA + hstep, voffA);
        if (wr == 1) PG8_BAR;
        PG8_WAIT_V(2); PG8_BAR;
        PG8_STAGE(PG8_SB(1, 0), cB + kstepB, voffB); PG8_STAGE(PG8_SA(1, 0), cA + kstep, voffA); PG8_STAGE(PG8_SB(1, 1), cB + hstepB + kstepB, voffB);
        PG8_WAIT_V(6); PG8_BAR;
    } else {
        PG8_STAGE(PG8_SB(0, 0), cB, voffB); PG8_STAGE(PG8_SA(0, 0), cA, voffA); PG8_STAGE(PG8_SB(0, 1), cB + hstepB, voffB); PG8_STAGE(PG8_SA(0, 1), cA + hstep, voffA);
        if (wr == 1) PG8_BAR;
        PG8_WAIT_V(4); PG8_BAR;
        PG8_STAGE(PG8_SB(1, 0), cB + kstepB, voffB); PG8_STAGE(PG8_SA(1, 0), cA + kstep, voffA); PG8_STAGE(PG8_SB(1, 1), cB + hstepB + kstepB, voffB);
        PG8_WAIT_V(6); PG8_BAR;
    }
    for (;;) {
        const bool has_next = S.next(ui + 1, nxt);
        const char* nA = has_next ? (const char*)g.A + (size_t)nxt.pm * tstep + (nxt.half == 2 ? hstep : (size_t)0) : cA; const char* nB = has_next ? (const char*)g.Bt + (size_t)nxt.pn * tstep : cB;
        const bool fullu = (cur.half == 0);
        for (int t = 0; t < nt; t += 2) {
            const bool last = (t == nt - 2);
            const char* a1 = cA + (size_t)(t + 1) * kstep;
            const char* a2 = last ? nA : cA + (size_t)(t + 2) * kstep; const char* b2 = last ? nB : cB + (size_t)(t + 2) * kstepB;
            const char* a3 = a2 + kstep; const char* b3 = b2 + kstepB;
            if (last && has_next) S.a_ready(nxt);
            if constexpr (SP2) {
            PG8_LDB(B0, 0, 0); PG8_LDB(B1, 0, 1); PG8_SCHED; PG8_LDA(At, 0, 0); PG8_STAGE(PG8_SA(1, 1), a1 + hstep, voffA);
            PG8_WAIT_V(8); PG8_WAIT_L(0); PG8_BAR; PG8_MMA(0, 0, At, B0); PG8_MMA(0, 1, At, B1); PG8_BAR; PG8_SCHED;
            PG8_LDA(At, 0, 1); PG8_STAGE(PG8_SB(0, 0), b2, voffB); PG8_STAGE(PG8_SB(0, 1), b2 + hstepB, voffB); PG8_STAGE(PG8_SA(0, 0), a2, voffA);
            PG8_WAIT_V(8); PG8_WAIT_L(0); PG8_BAR; if (fullu) { PG8_MMA(1, 0, At, B0); PG8_MMA(1, 1, At, B1); } PG8_BAR; PG8_SCHED;
            PG8_LDB(B0, 1, 0); PG8_LDB(B1, 1, 1); PG8_SCHED; PG8_LDA(At, 1, 0); PG8_STAGE(PG8_SA(0, 1), a2 + hstep, voffA);
            PG8_WAIT_V(8); PG8_WAIT_L(0); PG8_BAR; PG8_MMA(0, 0, At, B0); PG8_MMA(0, 1, At, B1); PG8_BAR; PG8_SCHED;
            PG8_LDA(At, 1, 1); PG8_STAGE(PG8_SB(1, 0), b3, voffB); PG8_STAGE(PG8_SB(1, 1), b3 + hstepB, voffB); PG8_STAGE(PG8_SA(1, 0), a3, voffA);
            PG8_WAIT_V(8); PG8_WAIT_L(0); PG8_BAR; if (fullu) { PG8_MMA(1, 0, At, B0); PG8_MMA(1, 1, At, B1); } PG8_BAR; PG8_SCHED;
            } else {
            PG8_LDB(B0, 0, 0); PG8_SCHED; PG8_LDA(At, 0, 0); PG8_STAGE(PG8_SA(1, 1), a1 + hstep, voffA);
            PG8_WAIT_L(8); PG8_BAR; PG8_WAIT_L(0); PG8_MMA(0, 0, At, B0); PG8_BAR; PG8_SCHED;
            PG8_LDB(B1, 0, 1); PG8_STAGE(PG8_SB(0, 0), b2, voffB);
            PG8_BAR; PG8_WAIT_L(0); PG8_MMA(0, 1, At, B1); PG8_BAR;
            PG8_LDA(At, 0, 1); PG8_STAGE(PG8_SA(0, 0), a2, voffA);
            PG8_BAR; PG8_WAIT_L(0); PG8_MMA(1, 0, At, B0); PG8_BAR; PG8_SCHED;
            PG8_STAGE(PG8_SB(0, 1), b2 + hstepB, voffB);
            PG8_WAIT_V(6); PG8_BAR; PG8_MMA(1, 1, At, B1); PG8_BAR;
            PG8_LDB(B0, 1, 0); PG8_SCHED; PG8_LDA(At, 1, 0); PG8_STAGE(PG8_SA(0, 1), a2 + hstep, voffA);
            PG8_WAIT_L(8); PG8_BAR; PG8_WAIT_L(0); PG8_MMA(0, 0, At, B0); PG8_BAR; PG8_SCHED;
            PG8_LDB(B1, 1, 1); PG8_STAGE(PG8_SB(1, 0), b3, voffB);
            PG8_BAR; PG8_WAIT_L(0); PG8_MMA(0, 1, At, B1); PG8_BAR;
            PG8_LDA(At, 1, 1); PG8_STAGE(PG8_SA(1, 0), a3, voffA);
            PG8_BAR; PG8_WAIT_L(0); PG8_MMA(1, 0, At, B0); PG8_BAR; PG8_SCHED;
            PG8_STAGE(PG8_SB(1, 1), b3 + hstepB, voffB);
            PG8_WAIT_V(6); PG8_BAR; PG8_MMA(1, 1, At, B1); PG8_BAR;
            }
        }
        if constexpr (ALIGN_EPI) { if (wr == 0) PG8_BAR; }
        if constexpr (!Epi::AFTER_DRAIN) { if constexpr (Epi::HAS_PRE) E(acc, cur, wr, wc, fr, fq, pre); else E(acc, cur, wr, wc, fr, fq); S.done(cur); }
        if constexpr (Epi::HAS_PRE) { if (has_next) E.prefetch(nxt, wr, wc, fr, fq, pre); }
        if (!has_next) break;
#pragma unroll
        for (int a = 0; a < 2; ++a)
#pragma unroll
            for (int b = 0; b < 2; ++b)
#pragma unroll
                for (int m = 0; m < 4; ++m)
#pragma unroll
                    for (int n = 0; n < 2; ++n) acc[a][b][m][n] = (f32x4){0.f, 0.f, 0.f, 0.f};
        cur = nxt; cA = nA; cB = nB; ++ui;
        if constexpr (ALIGN_EPI) { if (wr == 1) PG8_BAR; }
    }
    u32x4 pbv[2][4][2];
    if constexpr (Epi::AFTER_DRAIN) E.preload(cur, wr, wc, fr, fq, pbv);
    PG8_WAIT_V(0);
    if constexpr (!ALIGN_EPI) { if (wr == 0) PG8_BAR; }
    PG8_BAR;
    if constexpr (Epi::AFTER_DRAIN) { E.fused(acc, cur, wr, wc, fr, fq, lds, wid, lane, pbv); S.done(cur); }
#undef PG8_SA
#undef PG8_SB
#undef PG8_STAGE
#undef PG8_LDA
#undef PG8_LDB
#undef PG8_MMA
#undef PG8_WAIT_V
#undef PG8_WAIT_L
#undef PG8_BAR
#undef PG8_SCHED
}
}
#define LAS __attribute__((address_space(3)))
typedef unsigned short bf16;
typedef unsigned v4u __attribute__((ext_vector_type(4)));
typedef unsigned v2u __attribute__((ext_vector_type(2)));
typedef float f32x4 __attribute__((ext_vector_type(4)));
typedef float f32x2 __attribute__((ext_vector_type(2)));
typedef short bf16x8 __attribute__((ext_vector_type(8)));

constexpr int NWAVES = 8;
constexpr int M = 16384, D = 1024, DIN = 1536, LW = 512, FF = 2816, N13 = 2 * FF, SEQ = 8192, TC = 64, NCHUNK = M / TC;
constexpr float EPS = 1e-6f;
constexpr size_t MiB = 1u << 20;
constexpr size_t WS_SS1 = 0, WS_SS2 = 65536, WS_BAR = 131072, WS_CNT = WS_BAR + 16384, WS_SB = WS_BAR + 32768, BAR_BYTES = 32768 + 8192, WS_AGG = 1 * MiB;
constexpr size_t WS_WIN = 2 * MiB, WS_WOUT = 5 * MiB, WS_W13 = 7 * MiB, WS_W2 = 18 * MiB, WS_WGA = 24 * MiB, WS_WGX = WS_WGA + 65536, WS_WP = WS_WGA + 131072;
constexpr size_t WS_XN = 32 * MiB;
constexpr size_t WS_H1B = 64 * MiB;
constexpr size_t WS_U = 96 * MiB;
constexpr size_t WS_H = 144 * MiB;
constexpr size_t WS_END = 232 * MiB;
constexpr int RING_BYTES = 131072, TSTR = 1040, PT_OFF = 64 * TSTR  , SS_OFF = PT_OFF + 79 * TSTR  , CARRY_OFF = SS_OFF + 2048, LDS_BYTES = 155648, MISC_OFF = LDS_BYTES - 128;

#define LDS_WAIT() asm volatile("s_waitcnt lgkmcnt(0)" ::: "memory")
__device__ __forceinline__ float bf_lo(unsigned w) { return __uint_as_float(w << 16); }
__device__ __forceinline__ float bf_hi(unsigned w) { return __uint_as_float(w & 0xffff0000u); }
__device__ __forceinline__ float bf_s(unsigned short h) { return __uint_as_float(((unsigned)h) << 16); }
__device__ __forceinline__ unsigned pk2(float lo, float hi) { return pg8::cvt_pk_bf16(lo, hi); }
__device__ __forceinline__ void unpack8(const v4u v, float (&c)[8]) { c[0] = bf_lo(v.x); c[1] = bf_hi(v.x); c[2] = bf_lo(v.y); c[3] = bf_hi(v.y); c[4] = bf_lo(v.z); c[5] = bf_hi(v.z); c[6] = bf_lo(v.w); c[7] = bf_hi(v.w); }
__device__ __forceinline__ float sigmoid_(float x) { return __builtin_amdgcn_rcpf(1.0f + __expf(-x)); }
__device__ __forceinline__ float nexpm1(float x) {
    const float p = x * (1.0f + x * (0.5f + x * (0.16666667f + x * (0.041666668f + x * (0.0083333338f + x * (0.0013888889f + x * 0.0001984127f))))));
    const float e = 1.0f - __expf(x);
    return x > -0.25f ? -p : e;
}
__device__ __forceinline__ float one_minus_a2(float la, float a) {
    (void)la; return 1.0f - a * a;
}
__device__ __forceinline__ float wave_sum(float v) {
#pragma unroll
    for (int o = 1; o < 64; o <<= 1) v += __shfl_xor(v, o);
    return v;
}

struct TItem { const float* W; bf16* WT; const float* kscale; int N, ldt, k0, n0, drow0; };
__device__ __forceinline__ void t_load(const TItem& it, int lane, f32x4 (&t)[8]) {
#pragma unroll
    for (int i = 0; i < 8; ++i) t[i] = *(const f32x4*)(it.W + (size_t)(it.k0 + 8 * i + (lane >> 3)) * it.N + it.n0 + 4 * (lane & 7));
}
__device__ __forceinline__ void t_proc(const TItem& it, const f32x4 (&t)[8], LAS float* scr, int lane) {
#pragma unroll
    for (int i = 0; i < 8; ++i) { LAS float* d = scr + (8 * i + (lane >> 3)) * 33 + 4 * (lane & 7); d[0] = t[i][0]; d[1] = t[i][1]; d[2] = t[i][2]; d[3] = t[i][3]; }
    LDS_WAIT(); asm volatile("" ::: "memory");
    const int c = lane & 7;
    float ks[8];
#pragma unroll
    for (int i = 0; i < 8; ++i) ks[i] = it.kscale ? it.kscale[it.k0 + 8 * c + i] : 1.0f;
#pragma unroll
    for (int j = 0; j < 4; ++j) { const int n = (lane >> 3) + 8 * j; const LAS float* sp = scr + (8 * c) * 33 + n;
        v4u o; o.x = pk2(sp[0 * 33] * ks[0], sp[1 * 33] * ks[1]); o.y = pk2(sp[2 * 33] * ks[2], sp[3 * 33] * ks[3]); o.z = pk2(sp[4 * 33] * ks[4], sp[5 * 33] * ks[5]); o.w = pk2(sp[6 * 33] * ks[6], sp[7 * 33] * ks[7]);
        *(v4u*)(it.WT + (size_t)(it.drow0 + n) * it.ldt + it.k0 + 8 * c) = o; }
    LDS_WAIT(); asm volatile("" ::: "memory");
}
#define T_RUN(first, stride, n, DEC, scr, lane) do { int it_ = (first); if (it_ < (n)) { TItem cur_; f32x4 ta_[8]; DEC(it_, cur_); t_load(cur_, (lane), ta_); \
        for (;;) { const int nx_ = it_ + (stride); const bool has_ = nx_ < (n); TItem nxt_ = cur_; f32x4 tb_[8]; if (has_) { DEC(nx_, nxt_); t_load(nxt_, (lane), tb_); } \
            t_proc(cur_, ta_, (scr), (lane)); if (!has_) break; cur_ = nxt_; _Pragma("unroll") for (int q_ = 0; q_ < 8; ++q_) ta_[q_] = tb_[q_]; it_ = nx_; } } } while (0)

struct BTile { const float* W; bf16* WT; const float* kscale; int N, ldt, k0, n0, mode; };
__device__ __forceinline__ void bt_load(const BTile& t, int wave, int lane, f32x4 (&r)[8], f32x4 (&ksv)[2]) {
    if (t.kscale) { ksv[0] = *(const f32x4*)(t.kscale + t.k0 + 8 * (lane & 7)); ksv[1] = *(const f32x4*)(t.kscale + t.k0 + 8 * (lane & 7) + 4); }
    else { ksv[0] = (f32x4){1.f, 1.f, 1.f, 1.f}; ksv[1] = ksv[0]; }
#pragma unroll
    for (int i = 0; i < 8; ++i) r[i] = *(const f32x4*)(t.W + (size_t)(t.k0 + 8 * wave + i) * t.N + t.n0 + 4 * lane);
}
__device__ __forceinline__ void bt_proc(const BTile& t, const f32x4 (&r)[8], const f32x4 (&ksv)[2], LAS float* tile  , int wave, int lane) {
    const int c = lane & 7, nr = lane >> 3;
    const float ks[8] = {ksv[0][0], ksv[0][1], ksv[0][2], ksv[0][3], ksv[1][0], ksv[1][1], ksv[1][2], ksv[1][3]};
#pragma unroll
    for (int i = 0; i < 8; ++i) { LAS float* d = tile + (8 * wave + i) * 257 + 4 * lane; d[0] = r[i][0]; d[1] = r[i][1]; d[2] = r[i][2]; d[3] = r[i][3]; }
    __syncthreads();
#pragma unroll
    for (int j = 0; j < 4; ++j) { const int n = 32 * wave + 8 * j + nr; const LAS float* sp = tile + (8 * c) * 257 + n;
        v4u o; o.x = pk2(sp[0 * 257] * ks[0], sp[1 * 257] * ks[1]); o.y = pk2(sp[2 * 257] * ks[2], sp[3 * 257] * ks[3]); o.z = pk2(sp[4 * 257] * ks[4], sp[5 * 257] * ks[5]); o.w = pk2(sp[6 * 257] * ks[6], sp[7 * 257] * ks[7]);
        const int gn = t.n0 + n, drow = t.mode == 0 ? gn : 256 * (gn >> 7) + (gn & 127) + (t.mode == 2 ? 128 : 0);
        *(v4u*)(t.WT + (size_t)(drow >> 8) * (256 * (size_t)t.ldt) + (size_t)(t.k0 >> 6) * (256 * 64) + (size_t)(drow & 255) * 64 + 8 * c) = o; }
    __syncthreads();
}

#define XB_TMO      128
#define XB_XCNT(j)  (256  + 64 * (j))
#define XB_XSUB(j)  (1280 + 64 * (j))
#define XB_XGEN(j)  (2304 + 64 * (j))
#define XB_TOP      3328
#define XB_TOPGEN   3392
#define XCD_BAR_WORDS 3456
#define XB_SPIN_CAP (1u << 18)

__device__ __forceinline__ unsigned xb_ld(unsigned* p)              { return __hip_atomic_load(p, __ATOMIC_RELAXED, __HIP_MEMORY_SCOPE_AGENT); }
__device__ __forceinline__ unsigned xb_add(unsigned* p, unsigned v) { return __hip_atomic_fetch_add(p, v, __ATOMIC_RELAXED, __HIP_MEMORY_SCOPE_AGENT); }
__device__ __forceinline__ unsigned xb_xcc_id() { return (unsigned)__builtin_amdgcn_s_getreg((3 << 11) | 20) & 0xFu; }
#define XB_SPIN(cond, bar) do { unsigned _sp = 0; while (cond) { __builtin_amdgcn_s_sleep(1); \
    if ((++_sp & 255u) == 0u) { if (xb_ld(&(bar)[XB_TMO])) break; if (_sp > XB_SPIN_CAP) { atomicAdd(&(bar)[XB_TMO], 1u); break; } } } } while (0)

struct XcdBarrier {
    unsigned* bar; unsigned x;
    volatile LAS unsigned* st;
};

__device__ __forceinline__ XcdBarrier xcd_barrier_post(unsigned* bar, volatile LAS unsigned* st) {
    XcdBarrier b; b.bar = bar; b.x = xb_xcc_id(); b.st = st;
    if (threadIdx.x == 0) (void)xb_add(&bar[XB_XCNT(b.x)], 1u);
    return b;
}
__device__ __forceinline__ void xcd_barrier_complete(unsigned* bar, unsigned x, unsigned& nloc, unsigned& nx) {
    const unsigned G = gridDim.x * gridDim.y * gridDim.z;
    unsigned sum, cnt, mine, sp = 0u;
    for (;;) {
        sum = 0u; cnt = 0u; mine = 0u;
#pragma unroll
        for (unsigned j = 0; j < 16; ++j) { const unsigned c = xb_ld(&bar[XB_XCNT(j)]); sum += c; cnt += (c > 0u) ? 1u : 0u; mine = (j == x) ? c : mine; }
        if (sum == G) break;
        __builtin_amdgcn_s_sleep(1);
        if ((++sp & 255u) == 0u) { if (xb_ld(&bar[XB_TMO])) break; if (sp > XB_SPIN_CAP) { atomicAdd(&bar[XB_TMO], 1u); break; } }
    }
    nloc = mine > 0u ? mine : 1u; nx = cnt > 0u ? cnt : 1u;
}

__device__ __forceinline__ void xcd_barrier(const XcdBarrier& b) {
    asm volatile("s_waitcnt vmcnt(0)" ::: "memory");
    __syncthreads();
    if (threadIdx.x == 0) {
        unsigned* bar = b.bar;
        __builtin_amdgcn_s_waitcnt(0);
        unsigned nloc = b.st[0], nx = b.st[1];
        if (nloc == 0u) { xcd_barrier_complete(bar, b.x, nloc, nx); b.st[0] = nloc; b.st[1] = nx; }
        const unsigned old = xb_add(&bar[XB_XSUB(b.x)], 1u);
        const unsigned gen = old / nloc;
        if (old + 1u == (gen + 1u) * nloc) {
            __builtin_amdgcn_fence(__ATOMIC_RELEASE, "agent");
            asm volatile("s_waitcnt vmcnt(0)" ::: "memory");
            const unsigned og = xb_add(&bar[XB_TOP], 1u);
            const unsigned tg = og / nx;
            if (og + 1u == (tg + 1u) * nx) xb_add(&bar[XB_TOPGEN], 1u);
            else XB_SPIN(xb_ld(&bar[XB_TOPGEN]) == tg, bar);
            __builtin_amdgcn_fence(__ATOMIC_ACQUIRE, "agent");
            xb_add(&bar[XB_XGEN(b.x)], 1u);
            asm volatile("s_waitcnt vmcnt(0)" ::: "memory");
        } else {
            XB_SPIN(xb_ld(&bar[XB_XGEN(b.x)]) == gen, bar);
            __builtin_amdgcn_fence(__ATOMIC_ACQUIRE, "agent");
            asm volatile("s_waitcnt vmcnt(0)" ::: "memory");
        }
    }
    __syncthreads();
}

__device__ __forceinline__ void sb_arrive(unsigned* ctr) {
    asm volatile("s_waitcnt vmcnt(0)" ::: "memory");
    __syncthreads();
    if (threadIdx.x == 0) { __builtin_amdgcn_fence(__ATOMIC_RELEASE, "agent"); asm volatile("s_waitcnt vmcnt(0)" ::: "memory"); __hip_atomic_fetch_add(ctr, 1u, __ATOMIC_RELAXED, __HIP_MEMORY_SCOPE_AGENT); }
}
__device__ __forceinline__ void sb_wait(unsigned* ctr, unsigned n) {
    if (threadIdx.x == 0) { unsigned sp = 0;
        while (__hip_atomic_load(ctr, __ATOMIC_RELAXED, __HIP_MEMORY_SCOPE_AGENT) < n) { __builtin_amdgcn_s_sleep(1); if (++sp > (1u << 22)) break; }
        __builtin_amdgcn_fence(__ATOMIC_ACQUIRE, "agent"); asm volatile("s_waitcnt vmcnt(0)" ::: "memory"); }
    __syncthreads();
}
__device__ __forceinline__ void sbx_arrive(unsigned* sub, const XcdBarrier& b) {
    asm volatile("s_waitcnt vmcnt(0)" ::: "memory");
    __syncthreads();
    if (threadIdx.x == 0) { const unsigned nloc = b.st[0];
        const unsigned old = __hip_atomic_fetch_add(sub + 64 * b.x, 1u, __ATOMIC_RELAXED, __HIP_MEMORY_SCOPE_AGENT);
        if (old + 1u == nloc) { __builtin_amdgcn_fence(__ATOMIC_RELEASE, "agent"); asm volatile("s_waitcnt vmcnt(0)" ::: "memory"); __hip_atomic_fetch_add(sub + 64 * 16, 1u, __ATOMIC_RELAXED, __HIP_MEMORY_SCOPE_AGENT); } }
}
__device__ __forceinline__ void sbx_wait(unsigned* sub, const XcdBarrier& b) {
    if (threadIdx.x == 0) { const unsigned nx = b.st[1]; unsigned sp = 0;
        while (__hip_atomic_load(sub + 64 * 16, __ATOMIC_RELAXED, __HIP_MEMORY_SCOPE_AGENT) < nx) { __builtin_amdgcn_s_sleep(1); if (++sp > (1u << 22)) break; }
        __builtin_amdgcn_fence(__ATOMIC_ACQUIRE, "agent"); asm volatile("s_waitcnt vmcnt(0)" ::: "memory"); }
    __syncthreads();
}
#ifndef WGM_P1
#define WGM_P1 8
#define WGM_P3 8
#define WGM_P4 4
#define WGM_P5 8
#endif
struct Args { const float* in[21]; float* out; unsigned char* ws; };

__global__ void __launch_bounds__(NWAVES * 64, 2) fwd_mega(Args args) {
    extern __shared__ __attribute__((aligned(16))) unsigned char lds_raw[];
    LAS unsigned char* lds = (LAS unsigned char*)lds_raw;
    cg::grid_group grid = cg::this_grid();
    if (args.ws == nullptr) grid.sync();
    { volatile LAS unsigned* misc = (volatile LAS unsigned*)((LAS unsigned char*)lds_raw + MISC_OFF); if (threadIdx.x < 32) misc[threadIdx.x] = 0u; }
    __syncthreads();
    const XcdBarrier gbar = xcd_barrier_post((unsigned*)(args.ws + WS_BAR), (volatile LAS unsigned*)((LAS unsigned char*)lds_raw + MISC_OFF) + 8);
#define GRID_SYNC() xcd_barrier(gbar)
    const int tid = threadIdx.x, lane = tid & 63, wave = __builtin_amdgcn_readfirstlane(tid >> 6);
    const int G = gridDim.x, bx = blockIdx.x;
    unsigned char* ws = args.ws;
    const float* x = args.in[0]; float* out = args.out;
    float* rowss1 = (float*)(ws + WS_SS1); float* rowss2 = (float*)(ws + WS_SS2); f32x2* agg = (f32x2*)(ws + WS_AGG);
    bf16* Win_t = (bf16*)(ws + WS_WIN); bf16* Wout_t = (bf16*)(ws + WS_WOUT); bf16* W13_t = (bf16*)(ws + WS_W13); bf16* W2_t = (bf16*)(ws + WS_W2);
    bf16* WGA_t = (bf16*)(ws + WS_WGA); bf16* WGX_t = (bf16*)(ws + WS_WGX); bf16* WP_t = (bf16*)(ws + WS_WP);
    bf16* XN = (bf16*)(ws + WS_XN); bf16* Y = XN; bf16* H1B = (bf16*)(ws + WS_H1B); bf16* U = (bf16*)(ws + WS_U); bf16* HB = (bf16*)(ws + WS_H);

    {
        const int gw = bx * NWAVES + wave, NGW = G * NWAVES;
        for (int i = bx * (NWAVES * 64) + tid; i < 2 * M; i += G * NWAVES * 64) rowss1[i] = 0.f;
        LAS float* scr = (LAS float*)(lds + wave * 16384);
        constexpr int I_IN = (D / 64) * (DIN / 32), I_G = 16, I_P = 32;
        constexpr int NITEMS = I_IN + 2 * I_G + I_P;
#define DEC_P0(r_, T_) do { int r = (r_); \
            if (r < I_IN) { const int nb = r % (DIN / 32), kb = r / (DIN / 32); T_ = TItem{args.in[2], Win_t, nullptr, DIN, D, 64 * kb, 32 * nb, 32 * nb}; } \
            else if ((r -= I_IN) < I_G) { const int hh = r >> 1, nb = r & 1; T_ = TItem{args.in[5] + hh * 4096, WGA_t + hh * 4096, nullptr, 64, 64, 0, 32 * nb, 32 * nb}; } \
            else if ((r -= I_G) < I_G) { const int hh = r >> 1, nb = r & 1; T_ = TItem{args.in[7] + hh * 4096, WGX_t + hh * 4096, nullptr, 64, 64, 0, 32 * nb, 32 * nb}; } \
            else { r -= I_G; const int gg = r >> 3, q8 = r & 7, kb = q8 >> 2, nb = q8 & 3; T_ = TItem{args.in[10] + gg * 16384, WP_t + gg * 16384, nullptr, 128, 128, 64 * kb, 32 * nb, 32 * nb}; } } while (0)
        T_RUN(gw, NGW, NITEMS, DEC_P0, scr, lane);
#undef DEC_P0
        const f32x4* gp = (const f32x4*)args.in[1] + lane;
        f32x4 gv[4];
#pragma unroll
        for (int j = 0; j < 4; ++j) gv[j] = gp[64 * j];
        constexpr int NGRP = M / 4;
        const int vb = (G == 256) ? ((bx & 7) * 32 + (bx >> 3)) : bx;
        for (int pass = 0; pass < 2; ++pass) {
            const int grp = 16 * vb + 8 * pass + wave; if (grp >= NGRP) break;
            const int m0 = grp * 4;
            f32x4 v[4][4]; float sq[4];
#pragma unroll
            for (int r = 0; r < 4; ++r) { const f32x4* xr = (const f32x4*)(x + (size_t)(m0 + r) * D) + lane;
#pragma unroll
                for (int j = 0; j < 4; ++j) v[r][j] = xr[64 * j]; }
#pragma unroll
            for (int r = 0; r < 4; ++r) { float s2 = 0.f;
#pragma unroll
                for (int j = 0; j < 4; ++j) { const f32x4 vv = v[r][j] * v[r][j]; s2 += (vv.x + vv.y) + (vv.z + vv.w); }
                sq[r] = s2; }
#pragma unroll
            for (int o = 1; o < 64; o <<= 1) {
#pragma unroll
                for (int r = 0; r < 4; ++r) sq[r] += __shfl_xor(sq[r], o); }
#pragma unroll
            for (int r = 0; r < 4; ++r) { const float rstd = __builtin_amdgcn_rsqf(sq[r] * (1.0f / D) + EPS);
                unsigned long long* o8 = (unsigned long long*)(XN + (size_t)(m0 + r) * D) + lane;
#pragma unroll
                for (int j = 0; j < 4; ++j) { const f32x4 y = v[r][j] * rstd * gv[j]; o8[64 * j] = (unsigned long long)pk2(y.x, y.y) | ((unsigned long long)pk2(y.z, y.w) << 32); } }
        }
    }
    GRID_SYNC();

    {
        pg8::Gemm g{XN, Win_t, M, DIN, D, 0}; pg8::StaticOrder S; S.init(M, DIN, G, bx, WGM_P1);
        pg8::EpiU E{U, DIN};
        pg8::gemm_phase<pg8::EpiU, pg8::StaticOrder, true, true>(lds, g, S, E);
        if (bx >= 128) {
            int lane_d; asm volatile("v_and_b32 %0, 63, %1" : "=v"(lane_d) : "v"(threadIdx.x));
            LAS float* tile = (LAS float*)lds;
            constexpr int T_OUT = (D / 64) * (D / 256), T_1 = (D / 64) * (FF / 256), T_2 = (FF / 64) * (D / 256), NT = T_OUT + 2 * T_1 + T_2;
#define DEC_BT(r_, T_) do { int r = (r_); \
                if (r < T_OUT) { const int nb = r % (D / 256), kb = r / (D / 256); T_ = BTile{args.in[15], Wout_t, (64 * kb < LW) ? args.in[13] : args.in[14] - LW, D, D, 64 * kb, 256 * nb, 0}; } \
                else if ((r -= T_OUT) < T_1) { const int nb = r % (FF / 256), kb = r / (FF / 256); T_ = BTile{args.in[17], W13_t, args.in[16], FF, D, 64 * kb, 256 * nb, 1}; } \
                else if ((r -= T_1) < T_1) { const int nb = r % (FF / 256), kb = r / (FF / 256); T_ = BTile{args.in[18], W13_t, args.in[16], FF, D, 64 * kb, 256 * nb, 2}; } \
                else { r -= T_1; const int nb = r % (D / 256), kb = r / (D / 256); T_ = BTile{args.in[19], W2_t, nullptr, D, FF, 64 * kb, 256 * nb, 0}; } } while (0)
            { int it = bx - 128; BTile cur; f32x4 ta[8], ka[2]; DEC_BT(it, cur); bt_load(cur, wave, lane_d, ta, ka);
              for (;;) { const int nx = it + 128; const bool has = nx < NT; BTile nxt = cur; f32x4 tb[8], kb2[2]; if (has) { DEC_BT(nx, nxt); bt_load(nxt, wave, lane_d, tb, kb2); }
                  bt_proc(cur, ta, ka, tile, wave, lane_d); if (!has) break; cur = nxt;
#pragma unroll
                  for (int q_ = 0; q_ < 8; ++q_) ta[q_] = tb[q_];
                  ka[0] = kb2[0]; ka[1] = kb2[1];
                  it = nx; } }
#undef DEC_BT
        }
    }
    GRID_SYNC();

    {
        int tid_l; asm volatile("v_mov_b32 %0, %1" : "=v"(tid_l) : "v"(threadIdx.x));
        const int tid = tid_l, lane = tid & 63;
        const int ci = (G == 256) ? ((bx & 7) * 32 + (bx >> 3)) : bx;
        const int b = ci >> 7, c = ci & 127, t0 = c * TC, grow0 = b * SEQ + t0;
        const int q = lane >> 4, c15 = lane & 15;
        LAS unsigned char* T = lds;
        LAS unsigned char* PT = lds + PT_OFF;
        LAS float* SS = (LAS float*)(lds + SS_OFF);
        LAS float* CARRY = (LAS float*)(lds + CARRY_OFF);
        const bf16* Ub = U + (size_t)(b * SEQ) * DIN;
        const v4u vz = (v4u){0u, 0u, 0u, 0u};
        v4u cvr[11];
        {
            v4u pv[10];
#pragma unroll
            for (int i = 0; i < 10; ++i) { const int p = tid + 512 * i, r = p >> 6, c16 = p & 63, t = t0 - 15 + r;
                pv[i] = (r < 79 && t >= 0) ? *(const v4u*)(Ub + (size_t)(t < 0 ? 0 : t) * DIN + 1024 + c16 * 8) : vz; }
            { const int tb = t0 + 8 * wave; const bf16* ul = Ub + lane * 8;
#pragma unroll
              for (int i = 0; i < 11; ++i) { const int t = tb - 3 + i; cvr[i] = (t >= 0) ? *(const v4u*)(ul + (size_t)(t < 0 ? 0 : t) * DIN) : vz; } }
#pragma unroll
            for (int i = 0; i < 10; ++i) { const int p = tid + 512 * i, r = p >> 6, c16 = p & 63; if (r < 79) *(LAS v4u*)(PT + r * TSTR + c16 * 16) = pv[i]; }
        }
        float hl[4][4][4]; unsigned ppk[4][4][2];
        {
        {
            const int ch0 = lane * 8;
            f32x2 cw[4][4], cb[4];
#pragma unroll
            for (int k = 0; k < 4; ++k) { const f32x4 w0 = *(const f32x4*)(args.in[3] + k * LW + ch0), w1 = *(const f32x4*)(args.in[3] + k * LW + ch0 + 4);
                cw[k][0] = (f32x2){w0[0], w0[1]}; cw[k][1] = (f32x2){w0[2], w0[3]}; cw[k][2] = (f32x2){w1[0], w1[1]}; cw[k][3] = (f32x2){w1[2], w1[3]}; }
            { const f32x4 w0 = *(const f32x4*)(args.in[4] + ch0), w1 = *(const f32x4*)(args.in[4] + ch0 + 4); cb[0] = (f32x2){w0[0], w0[1]}; cb[1] = (f32x2){w0[2], w0[3]}; cb[2] = (f32x2){w1[0], w1[1]}; cb[3] = (f32x2){w1[2], w1[3]}; }
            f32x2 r0[4], r1[4], r2[4];
#define P2_UNPK(v, dst) do { dst[0] = (f32x2){bf_lo((v).x), bf_hi((v).x)}; dst[1] = (f32x2){bf_lo((v).y), bf_hi((v).y)}; dst[2] = (f32x2){bf_lo((v).z), bf_hi((v).z)}; dst[3] = (f32x2){bf_lo((v).w), bf_hi((v).w)}; } while (0)
            P2_UNPK(cvr[0], r0); P2_UNPK(cvr[1], r1); P2_UNPK(cvr[2], r2);
#pragma unroll
            for (int i = 0; i < 8; ++i) { f32x2 cv[4], xc[4]; P2_UNPK(cvr[3 + i], cv);
#pragma unroll
                for (int j = 0; j < 4; ++j) { xc[j] = cb[j] + cw[0][j] * r0[j] + cw[1][j] * r1[j] + cw[2][j] * r2[j] + cw[3][j] * cv[j]; r0[j] = r1[j]; r1[j] = r2[j]; r2[j] = cv[j]; }
                v4u o; o.x = pk2(xc[0].x, xc[0].y); o.y = pk2(xc[1].x, xc[1].y); o.z = pk2(xc[2].x, xc[2].y); o.w = pk2(xc[3].x, xc[3].y);
                *(LAS v4u*)(T + (8 * wave + i) * TSTR + ch0 * 2) = o; }
#undef P2_UNPK
        }
        __syncthreads();
        {
            const int h = wave;
            const int sa16 = ((lane - 16) & 63) * 4, sa32 = ((lane - 32) & 63) * 4, sa48 = (48 + c15) * 4;
#define P2_BP(addr, v) __int_as_float(__builtin_amdgcn_ds_bpermute((addr), __float_as_int(v)))
#pragma unroll
            for (int ctp = 0; ctp < 2; ++ctp) {
                asm volatile("" ::: "memory");
                bf16x8 fa[2][2], fx[2][2]; float bav[2], bxv[2], sp8[2], Pc[2], Hc[2]; int ch[2];
#pragma unroll
                for (int e = 0; e < 2; ++e) { const int ct = 2 * ctp + e; ch[e] = h * 64 + ct * 16 + c15;
                    const bf16* wa_ = WGA_t + h * 4096 + (ct * 16 + c15) * 64 + 8 * q; const bf16* wx_ = WGX_t + h * 4096 + (ct * 16 + c15) * 64 + 8 * q;
                    fa[e][0] = *(const bf16x8*)wa_; fa[e][1] = *(const bf16x8*)(wa_ + 32); fx[e][0] = *(const bf16x8*)wx_; fx[e][1] = *(const bf16x8*)(wx_ + 32);
                    bav[e] = args.in[6][ch[e]]; bxv[e] = args.in[8][ch[e]]; const float lam = args.in[9][ch[e]];
                    sp8[e] = 8.0f * (fmaxf(-lam, 0.f) + log1pf(__expf(-fabsf(lam)))); Pc[e] = 1.f; Hc[e] = 0.f; }
#pragma unroll
                for (int rt = 0; rt < 4; ++rt) {
                    asm volatile("" ::: "memory");
                    const LAS unsigned char* ap = T + (rt * 16 + c15) * TSTR + (h * 64 + 8 * q) * 2;
                    const bf16x8 a0 = *(const LAS bf16x8*)ap, a1 = *(const LAS bf16x8*)(ap + 64);
                    f32x4 ar[2], ai[2]; float P[2][4], H[2][4], Pi[2], Hi[2], Pe[2], He[2], Pt[2], Ht[2];
#pragma unroll
                    for (int e = 0; e < 2; ++e) { ar[e] = (f32x4){0.f, 0.f, 0.f, 0.f}; ai[e] = (f32x4){0.f, 0.f, 0.f, 0.f};
                        ar[e] = __builtin_amdgcn_mfma_f32_16x16x32_bf16(a0, fa[e][0], ar[e], 0, 0, 0); ai[e] = __builtin_amdgcn_mfma_f32_16x16x32_bf16(a0, fx[e][0], ai[e], 0, 0, 0); }
#pragma unroll
                    for (int e = 0; e < 2; ++e) { ar[e] = __builtin_amdgcn_mfma_f32_16x16x32_bf16(a1, fa[e][1], ar[e], 0, 0, 0); ai[e] = __builtin_amdgcn_mfma_f32_16x16x32_bf16(a1, fx[e][1], ai[e], 0, 0, 0); }
#pragma unroll
                    for (int e = 0; e < 2; ++e) {
                        float av[4], bbv[4];
                        const f32x2 nl2 = (f32x2){-1.44269504f, -1.44269504f}, one2 = (f32x2){1.0f, 1.0f};
                        const f32x2 bav2 = (f32x2){bav[e], bav[e]}, bxv2 = (f32x2){bxv[e], bxv[e]}, nsl2 = (f32x2){-sp8[e] * 1.44269504f, -sp8[e] * 1.44269504f};
#pragma unroll
                        for (int jp = 0; jp < 2; ++jp) { const int tl = rt * 16 + 4 * q + 2 * jp;
                            const f32x2 xcv = (f32x2){bf_s(*(const LAS unsigned short*)(T + tl * TSTR + ch[e] * 2)), bf_s(*(const LAS unsigned short*)(T + (tl + 1) * TSTR + ch[e] * 2))};
                            const f32x2 tr = ((f32x2){ar[e][2 * jp], ar[e][2 * jp + 1]} + bav2) * nl2, ti = ((f32x2){ai[e][2 * jp], ai[e][2 * jp + 1]} + bxv2) * nl2;
                            f32x2 er, ei; er.x = __builtin_amdgcn_exp2f(tr.x); er.y = __builtin_amdgcn_exp2f(tr.y); ei.x = __builtin_amdgcn_exp2f(ti.x); ei.y = __builtin_amdgcn_exp2f(ti.y);
                            const f32x2 dr = er + one2, di = ei + one2;
                            f32x2 r, ig; r.x = __builtin_amdgcn_rcpf(dr.x); r.y = __builtin_amdgcn_rcpf(dr.y); ig.x = __builtin_amdgcn_rcpf(di.x); ig.y = __builtin_amdgcn_rcpf(di.y);
                            const f32x2 la2 = r * nsl2;
                            f32x2 a; a.x = __builtin_amdgcn_exp2f(la2.x); a.y = __builtin_amdgcn_exp2f(la2.y);
                            const f32x2 om = one2 - a * a;
                            f32x2 mult; mult.x = __builtin_amdgcn_sqrtf(fmaxf(om.x, 1e-12f)); mult.y = __builtin_amdgcn_sqrtf(fmaxf(om.y, 1e-12f));
                            const f32x2 bb = (mult * ig) * xcv;
                            av[2 * jp] = a.x; av[2 * jp + 1] = a.y; bbv[2 * jp] = bb.x; bbv[2 * jp + 1] = bb.y; }
                        P[e][0] = av[0]; H[e][0] = bbv[0];
#pragma unroll
                        for (int j = 1; j < 4; ++j) { P[e][j] = av[j] * P[e][j - 1]; H[e][j] = av[j] * H[e][j - 1] + bbv[j]; } }
#pragma unroll
                    for (int e = 0; e < 2; ++e) { Pi[e] = P[e][3]; Hi[e] = H[e][3]; }
                    { float Pp[2], Hp[2];
#pragma unroll
                      for (int e = 0; e < 2; ++e) { Pp[e] = P2_BP(sa16, Pi[e]); Hp[e] = P2_BP(sa16, Hi[e]); }
#pragma unroll
                      for (int e = 0; e < 2; ++e) if (q >= 1) { Hi[e] = Pi[e] * Hp[e] + Hi[e]; Pi[e] = Pp[e] * Pi[e]; } }
                    { float Pp[2], Hp[2];
#pragma unroll
                      for (int e = 0; e < 2; ++e) { Pp[e] = P2_BP(sa32, Pi[e]); Hp[e] = P2_BP(sa32, Hi[e]); }
#pragma unroll
                      for (int e = 0; e < 2; ++e) if (q >= 2) { Hi[e] = Pi[e] * Hp[e] + Hi[e]; Pi[e] = Pp[e] * Pi[e]; } }
#pragma unroll
                    for (int e = 0; e < 2; ++e) { Pe[e] = P2_BP(sa16, Pi[e]); He[e] = P2_BP(sa16, Hi[e]); Pt[e] = P2_BP(sa48, Pi[e]); Ht[e] = P2_BP(sa48, Hi[e]); }
#pragma unroll
                    for (int e = 0; e < 2; ++e) { const int ct = 2 * ctp + e; if (q == 0) { Pe[e] = 1.f; He[e] = 0.f; }
                        const float Ppre = Pc[e] * Pe[e], Hpre = Pe[e] * Hc[e] + He[e];
#pragma unroll
                        for (int j = 0; j < 4; ++j) hl[ct][rt][j] = H[e][j] + P[e][j] * Hpre;
                        ppk[ct][rt][0] = pk2(P[e][0] * Ppre, P[e][1] * Ppre); ppk[ct][rt][1] = pk2(P[e][2] * Ppre, P[e][3] * Ppre);
                        asm volatile("" : "+v"(hl[ct][rt][0]), "+v"(hl[ct][rt][1]), "+v"(hl[ct][rt][2]), "+v"(hl[ct][rt][3]), "+v"(ppk[ct][rt][0]), "+v"(ppk[ct][rt][1]));
                        Hc[e] = Pt[e] * Hc[e] + Ht[e]; Pc[e] = Pc[e] * Pt[e]; }
                }
#pragma unroll
                for (int e = 0; e < 2; ++e) if (q == 0) agg[(size_t)ci * LW + ch[e]] = (f32x2){Pc[e], Hc[e]};
            }
#undef P2_BP
        }
        }
        sbx_arrive((unsigned*)(ws + WS_SB), gbar);
        {
            const int g = wave >> 1, th = wave & 1, ts = q, win = 2 << g, nh = th;
            const bf16* wp = WP_t + g * 16384 + (size_t)(nh * 64 + c15) * 128 + 8 * q;
            const int tl0 = th * 32 + ts * 8, tfirst = t0 + tl0;
            const LAS unsigned char* pp0 = PT + (tl0 + 15) * TSTR + (g * 128 + c15 * 8) * 2;
#define P2_UNPK4(v, dst) do { dst[0] = (f32x2){bf_lo((v).x), bf_hi((v).x)}; dst[1] = (f32x2){bf_lo((v).y), bf_hi((v).y)}; dst[2] = (f32x2){bf_lo((v).z), bf_hi((v).z)}; dst[3] = (f32x2){bf_lo((v).w), bf_hi((v).w)}; } while (0)
            f32x2 s[4];
#pragma unroll
            for (int j = 0; j < 4; ++j) s[j] = (f32x2){0.f, 0.f};
            for (int k = 1; k < win; ++k) { f32x2 cv[4]; const v4u lv = *(const LAS v4u*)(pp0 - k * TSTR); P2_UNPK4(lv, cv);
#pragma unroll
                for (int j = 0; j < 4; ++j) s[j] += cv[j]; }
#pragma unroll
            for (int i = 0; i < 8; ++i) { const int t = tfirst + i; f32x2 cv[4]; const v4u lv = *(const LAS v4u*)(pp0 + i * TSTR); P2_UNPK4(lv, cv);
                const float inv = 1.0f / (float)(t + 1 < win ? t + 1 : win); const f32x2 inv2 = (f32x2){inv, inv}; f32x2 p[4];
#pragma unroll
                for (int j = 0; j < 4; ++j) { s[j] += cv[j]; p[j] = s[j] * inv2 - cv[j]; }
                v4u o; o.x = pk2(p[0].x, p[0].y); o.y = pk2(p[1].x, p[1].y); o.z = pk2(p[2].x, p[2].y); o.w = pk2(p[3].x, p[3].y);
                *(LAS v4u*)(T + (tl0 + i) * TSTR + (g * 128 + c15 * 8) * 2) = o;
                f32x2 ov[4]; const v4u lo_ = *(const LAS v4u*)(pp0 + (i - win + 1) * TSTR); P2_UNPK4(lo_, ov);
#pragma unroll
                for (int j = 0; j < 4; ++j) s[j] -= ov[j]; }
#undef P2_UNPK4
            __syncthreads();
            f32x4 acc[4][4];
#pragma unroll
            for (int rt = 0; rt < 4; ++rt)
#pragma unroll
                for (int ct = 0; ct < 4; ++ct) acc[rt][ct] = (f32x4){0.f, 0.f, 0.f, 0.f};
            bf16x8 bfr[2][4];
#pragma unroll
            for (int ks = 0; ks < 4; ++ks) bfr[0][ks] = *(const bf16x8*)(wp + ks * 32);
#pragma unroll
            for (int ct = 0; ct < 4; ++ct) {
                asm volatile("" ::: "memory");
                if (ct < 3) {
#pragma unroll
                    for (int ks = 0; ks < 4; ++ks) bfr[(ct + 1) & 1][ks] = *(const bf16x8*)(wp + (ct + 1) * 2048 + ks * 32); }
#pragma unroll
                for (int rt = 0; rt < 4; ++rt)
#pragma unroll
                    for (int ks = 0; ks < 4; ++ks) { const bf16x8 a = *(const LAS bf16x8*)(T + (rt * 16 + c15) * TSTR + (g * 128 + ks * 32 + 8 * q) * 2);
                        acc[rt][ct] = __builtin_amdgcn_mfma_f32_16x16x32_bf16(bfr[ct & 1][ks], a, acc[rt][ct], 0, 0, 0); } }
            const int pc0 = g * 128 + nh * 64 + 4 * q;
            float ssq[4] = {0.f, 0.f, 0.f, 0.f};
#pragma unroll
            for (int ct = 0; ct < 4; ++ct) { const f32x4 pb = *(const f32x4*)(args.in[11] + pc0 + ct * 16), psc = *(const f32x4*)(args.in[12] + pc0 + ct * 16);
#pragma unroll
                for (int rt = 0; rt < 4; ++rt) { const f32x4 y = (acc[rt][ct] + pb) * psc; acc[rt][ct] = y; const f32x4 y2 = y * y; ssq[rt] += (y2[0] + y2[1]) + (y2[2] + y2[3]); } }
#pragma unroll
            for (int rt = 0; rt < 4; ++rt) { float v = ssq[rt]; v += __shfl_xor(v, 16); v += __shfl_xor(v, 32); if (q == 0) SS[(rt * 16 + c15) * 8 + wave] = v; }
            __syncthreads();
            float rstd[4];
#pragma unroll
            for (int rt = 0; rt < 4; ++rt) { const f32x4 s0 = *(const LAS f32x4*)(SS + (rt * 16 + c15) * 8), s1 = *(const LAS f32x4*)(SS + (rt * 16 + c15) * 8 + 4);
                rstd[rt] = __builtin_amdgcn_rsqf(((s0[0] + s0[1]) + (s0[2] + s0[3]) + (s1[0] + s1[1]) + (s1[2] + s1[3])) * (1.0f / 512.0f) + EPS); }
#pragma unroll
            for (int ct = 0; ct < 4; ++ct) {
#pragma unroll
                for (int rt = 0; rt < 4; ++rt) { const f32x4 y = acc[rt][ct] * rstd[rt]; v2u o; o.x = pk2(y[0], y[1]); o.y = pk2(y[2], y[3]);
                    *(LAS v2u*)(T + (rt * 16 + c15) * TSTR + (pc0 + ct * 16) * 2) = o; } }
            __syncthreads();
#pragma unroll
            for (int i = 0; i < 8; ++i) { const int p = tid + 512 * i, row = p >> 6, c16 = p & 63; const v4u v = *(const LAS v4u*)(T + row * TSTR + c16 * 16);
                pg8::st16(Y + (size_t)(grow0 + row) * D + 512 + c16 * 8, v); }
            __syncthreads();
        }
        sbx_wait((unsigned*)(ws + WS_SB), gbar);
        {
            const int h = wave;
            int tid_b; asm volatile("v_mov_b32 %0, %1" : "=v"(tid_b) : "v"(threadIdx.x));
            const int tid = tid_b, lane = tid & 63, q = lane >> 4, c15 = lane & 15;
            {
                LAS f32x2* SEG = (LAS f32x2*)PT;
                const f32x4* ag4 = (const f32x4*)(agg + (size_t)(b * 128) * LW) + lane;
#pragma unroll 1
                for (int kq = 0; kq < 4; ++kq) {
                    f32x4 v[16];
#pragma unroll
                    for (int i = 0; i < 16; ++i) { const int rw = 16 * wave + i, rc = rw < c ? rw : (c > 0 ? c - 1 : 0); v[i] = ag4[(size_t)rc * (LW / 2) + kq * 64]; }
                    f32x2 AA = (f32x2){1.f, 1.f}, BB = (f32x2){0.f, 0.f};
#pragma unroll
                    for (int i = 0; i < 16; ++i) { const bool on = (16 * wave + i) < c; const f32x2 a2 = on ? (f32x2){v[i][0], v[i][2]} : (f32x2){1.f, 1.f}, b2 = on ? (f32x2){v[i][1], v[i][3]} : (f32x2){0.f, 0.f};
                        BB = a2 * BB + b2; AA = AA * a2; }
                    *(LAS f32x4*)(SEG + wave * LW + kq * 128 + 2 * lane) = (f32x4){AA.x, BB.x, AA.y, BB.y};
                }
                asm volatile("" ::: "memory");
                { v4u gv8[8];
#pragma unroll
                  for (int i = 0; i < 8; ++i) { const int p = tid + 512 * i, row = p >> 6, c16 = p & 63; gv8[i] = *(const v4u*)(U + (size_t)(grow0 + row) * DIN + 512 + c16 * 8); }
#pragma unroll
                  for (int i = 0; i < 8; ++i) { const int p = tid + 512 * i, row = p >> 6, c16 = p & 63; *(LAS v4u*)(T + row * TSTR + c16 * 16) = gv8[i]; } }
                __syncthreads();
                float carry = 0.f;
#pragma unroll
                for (int w = 0; w < 8; ++w) { const f32x2 sg = SEG[w * LW + tid]; carry = sg.x * carry + sg.y; }
                CARRY[tid] = carry;
            }
            __syncthreads();
            float ss[4][4];
#pragma unroll
            for (int rt = 0; rt < 4; ++rt)
#pragma unroll
                for (int j = 0; j < 4; ++j) ss[rt][j] = 0.f;
#pragma unroll
            for (int ct = 0; ct < 4; ++ct) { asm volatile("" ::: "memory"); const int ch = h * 64 + ct * 16 + c15; const float cr = CARRY[ch];
#pragma unroll
                for (int rt = 0; rt < 4; ++rt)
#pragma unroll
                    for (int jp = 0; jp < 2; ++jp) { const int tl = rt * 16 + 4 * q + 2 * jp;
                        const f32x2 ug = (f32x2){bf_s(*(const LAS unsigned short*)(T + tl * TSTR + ch * 2)), bf_s(*(const LAS unsigned short*)(T + (tl + 1) * TSTR + ch * 2))};
                        const f32x2 ppv = (f32x2){bf_lo(ppk[ct][rt][jp]), bf_hi(ppk[ct][rt][jp])}, crv = (f32x2){cr, cr};
                        const f32x2 hf = (f32x2){hl[ct][rt][2 * jp], hl[ct][rt][2 * jp + 1]} + ppv * crv;
                        const f32x2 y = hf * ug, y2 = y * y;
                        hl[ct][rt][2 * jp] = y.x; hl[ct][rt][2 * jp + 1] = y.y; ss[rt][2 * jp] += y2.x; ss[rt][2 * jp + 1] += y2.y; } }
            {
                float w8[8], w4[4], w2[2];
                const bool b3 = (lane & 8) != 0, b2 = (lane & 4) != 0, b1 = (lane & 2) != 0, b0 = (lane & 1) != 0;
#pragma unroll
                for (int k = 0; k < 8; ++k) { const float lo = ss[k >> 2][k & 3], hi = ss[2 + (k >> 2)][k & 3]; const float keep = b3 ? hi : lo, send = b3 ? lo : hi; w8[k] = keep + __shfl_xor(send, 8); }
#pragma unroll
                for (int k = 0; k < 4; ++k) { const float keep = b2 ? w8[k + 4] : w8[k], send = b2 ? w8[k] : w8[k + 4]; w4[k] = keep + __shfl_xor(send, 4); }
#pragma unroll
                for (int k = 0; k < 2; ++k) { const float keep = b1 ? w4[k + 2] : w4[k], send = b1 ? w4[k] : w4[k + 2]; w2[k] = keep + __shfl_xor(send, 2); }
                const float keep = b0 ? w2[1] : w2[0], send = b0 ? w2[0] : w2[1]; const float tot = keep + __shfl_xor(send, 1);
                SS[((c15 >> 2) * 16 + 4 * q + (c15 & 3)) * 8 + h] = tot;
            }
            __syncthreads();
#pragma unroll
            for (int rt = 0; rt < 4; ++rt)
#pragma unroll
                for (int j = 0; j < 4; ++j) { const int tl = rt * 16 + 4 * q + j; const f32x4 s0 = *(const LAS f32x4*)(SS + tl * 8), s1 = *(const LAS f32x4*)(SS + tl * 8 + 4);
                    ss[rt][j] = __builtin_amdgcn_rsqf(((s0[0] + s0[1]) + (s0[2] + s0[3]) + (s1[0] + s1[1]) + (s1[2] + s1[3])) * (1.0f / 512.0f) + EPS); }
#pragma unroll
            for (int ct = 0; ct < 4; ++ct) { asm volatile("" ::: "memory"); const int ch = h * 64 + ct * 16 + c15;
#pragma unroll
                for (int rt = 0; rt < 4; ++rt)
#pragma unroll
                    for (int jp = 0; jp < 2; ++jp) { const int tl = rt * 16 + 4 * q + 2 * jp;
                        const f32x2 v = (f32x2){hl[ct][rt][2 * jp], hl[ct][rt][2 * jp + 1]} * (f32x2){ss[rt][2 * jp], ss[rt][2 * jp + 1]};
                        const unsigned pw = pk2(v.x, v.y);
                        *(LAS unsigned short*)(T + tl * TSTR + ch * 2) = (unsigned short)(pw & 0xffffu); *(LAS unsigned short*)(T + (tl + 1) * TSTR + ch * 2) = (unsigned short)(pw >> 16); } }
            __syncthreads();
#pragma unroll
            for (int i = 0; i < 8; ++i) { const int p = tid + 512 * i, row = p >> 6, c16 = p & 63; const v4u v = *(const LAS v4u*)(T + row * TSTR + c16 * 16);
                pg8::st16(Y + (size_t)(grow0 + row) * D + c16 * 8, v); }
        }
    }
    GRID_SYNC();

    {
        pg8::Gemm g{Y, Wout_t, M, D, D, 1}; pg8::StaticOrder S; S.init(M, D, G, bx, WGM_P3);
        pg8::EpiRes3 E{x, H1B, rowss1};
        pg8::gemm_phase<pg8::EpiRes3, pg8::StaticOrder, true, true>(lds, g, S, E);
    }
    GRID_SYNC();

    {
        pg8::Gemm g{H1B, W13_t, M, N13, D, 1}; pg8::TailSplitOrder S; S.init(M, N13, G, bx, WGM_P4);
        pg8::EpiFfn E{HB, rowss1};
        pg8::gemm_phase<pg8::EpiFfn, pg8::TailSplitOrder, true, true>(lds, g, S, E);
    }
    GRID_SYNC();

    {
        pg8::Gemm g{HB, W2_t, M, D, FF, 1}; pg8::StaticOrder S; S.init(M, D, G, bx, WGM_P5);
        pg8::EpiFinal E{H1B, out, args.in[20], (float*)(ws + WS_AGG), (unsigned*)(ws + WS_CNT)};
        pg8::gemm_phase<pg8::EpiFinal, pg8::StaticOrder, false, true>(lds, g, S, E);
    }
}

extern "C" void kernel_launch(void* const* d_in, const int* in_sizes, int n_in, void* d_out, int out_size, void* d_ws, size_t ws_size, hipStream_t stream) {
    static int grid = 0;
    if (grid == 0) {
        if (n_in != 21 || out_size != M * D || ws_size < WS_END) { fprintf(stderr, "kernel_launch: unexpected shapes n_in %d out %d ws %zu\n", n_in, out_size, ws_size); grid = -1; return; }
        int dev = 0, cus = 0, per_cu = 0;
        (void)hipGetDevice(&dev); (void)hipDeviceGetAttribute(&cus, hipDeviceAttributeMultiprocessorCount, dev);
        if (hipFuncSetAttribute((const void*)fwd_mega, hipFuncAttributeMaxDynamicSharedMemorySize, LDS_BYTES) != hipSuccess) { fprintf(stderr, "kernel_launch: hipFuncSetAttribute failed\n"); grid = -1; return; }
        (void)hipOccupancyMaxActiveBlocksPerMultiprocessor(&per_cu, (const void*)fwd_mega, NWAVES * 64, LDS_BYTES);
        (void)hipGetLastError();
        if (cus * per_cu < 256) fprintf(stderr, "kernel_launch: co-resident capacity %d x %d < 256 workgroups\n", cus, per_cu);
        grid = 256;
    }
    if (grid < 0) return;
    Args a{};
    for (int i = 0; i < 21; ++i) a.in[i] = (const float*)d_in[i];
    a.out = (float*)d_out; a.ws = (unsigned char*)d_ws;
    if (hipMemsetAsync((char*)d_ws + WS_BAR, 0, BAR_BYTES, stream) != hipSuccess) { fprintf(stderr, "kernel_launch: hipMemsetAsync failed\n"); return; }
    void* kargs[] = {&a};
    hipError_t e = hipLaunchCooperativeKernel((const void*)fwd_mega, dim3(grid), dim3(NWAVES * 64), kargs, LDS_BYTES, stream);
    if (e != hipSuccess) fprintf(stderr, "kernel_launch: cooperative launch failed: %s\n", hipGetErrorString(e));
}
```
